# Optimizing an MI355X kernel written in HIP

```python
import math
import jax, jax.numpy as jnp
from jax import lax
import numpy as np

D_MODEL = 1024
BATCH = 32
SEQ = 2048
DEPTH = 1

D_SSM = D_MODEL // 2
SSM_GROUP = 16
N_SSM_GROUPS = D_SSM // SSM_GROUP
SSM_STATE = 64
D_CONV = D_MODEL // 2
CONV_WIDTH = 3
D_FF = 4 * D_MODEL
N_BRANCH = 2
N_MOD = 6
RMS_EPS = 1e-6
DT_MIN = 1e-3
DT_MAX = 1e-1
IN_COLS = D_SSM + 3 * D_CONV + N_BRANCH * D_MODEL

kernel_name = "hybrid_s5_shortconv_gated_adaln_block"


def rmsnorm(x, g):
    xf = x.astype(jnp.float32)
    y = xf * lax.rsqrt(jnp.mean(xf * xf, axis=-1, keepdims=True) + RMS_EPS)
    return (y * g.astype(jnp.float32)).astype(x.dtype)


def modulate(h, shift, scale):
    return h * (1 + scale[:, None, :]) + shift[:, None, :]


def s5_mimo(u, lam_re, lam_im, log_dt, b_re, b_im, c_re, c_im, d_skip):
    f32 = jnp.float32
    n_len = u.shape[1]
    u32 = u.astype(f32)
    lam = lax.complex(lam_re.astype(f32), lam_im.astype(f32))
    dt = jnp.exp(log_dt.astype(f32))[:, None]
    lam_bar = jnp.exp(lam * dt)
    b = lax.complex(b_re.astype(f32), b_im.astype(f32))
    b_bar = ((lam_bar - 1) / lam)[..., None] * b
    bu = jnp.einsum('blgh,gph->blgp', u32.astype(jnp.complex64), b_bar)
    a = jnp.broadcast_to(lam_bar[None, None], (1, n_len) + lam_bar.shape)

    def combine(e1, e2):
        a1, s1 = e1
        a2, s2 = e2
        return a1 * a2, a2 * s1 + s2

    _, states = lax.associative_scan(combine, (a, bu), axis=1)
    c = lax.complex(c_re.astype(f32), c_im.astype(f32))
    y = jnp.real(jnp.einsum('blgp,ghp->blgh', states, c))
    y = y + d_skip.astype(f32) * u32
    return y.astype(u.dtype)


def short_gated_conv(cx, cb, cc, conv_w):
    v = cc * cx
    w = conv_w.astype(v.dtype)[:, None, :]
    y = lax.conv_general_dilated(
        v, w, window_strides=(1,), padding=[(CONV_WIDTH - 1, 0)],
        dimension_numbers=('NWC', 'WIO', 'NWC'), feature_group_count=D_CONV)
    return cb * y


def setup_inputs(seed: int = 0) -> dict:
    key = jax.random.key(seed)
    ks = jax.random.split(key, 24)
    f32 = jnp.float32
    G, H, P = N_SSM_GROUPS, SSM_GROUP, SSM_STATE

    def nrm(k, shape, scale):
        return jax.random.normal(k, shape, f32) * scale

    x = jax.random.normal(ks[0], (BATCH, SEQ, D_MODEL), f32)
    c = jax.random.normal(ks[1], (BATCH, D_MODEL), f32)
    norm1_g = 1.0 + nrm(ks[2], (DEPTH, D_MODEL), 0.02)
    norm2_g = 1.0 + nrm(ks[3], (DEPTH, D_MODEL), 0.02)
    w_ada = nrm(ks[4], (DEPTH, D_MODEL, N_MOD * D_MODEL), 0.5 * D_MODEL ** -0.5)
    b_ada = nrm(ks[5], (DEPTH, N_MOD * D_MODEL), 0.01)
    w_in = nrm(ks[6], (DEPTH, D_MODEL, IN_COLS), D_MODEL ** -0.5)
    lam_re = -0.5 + nrm(ks[7], (DEPTH, G, P), 0.02)
    lam_im = math.pi * jnp.arange(P, dtype=f32)[None, None, :] + nrm(ks[8], (DEPTH, G, P), 0.02)
    log_dt = jax.random.uniform(ks[9], (DEPTH, G), f32, math.log(DT_MIN), math.log(DT_MAX))
    b_re = nrm(ks[10], (DEPTH, G, P, H), (2 * H) ** -0.5)
    b_im = nrm(ks[11], (DEPTH, G, P, H), (2 * H) ** -0.5)
    c_re = nrm(ks[12], (DEPTH, G, H, P), P ** -0.5)
    c_im = nrm(ks[13], (DEPTH, G, H, P), P ** -0.5)
    d_skip = nrm(ks[14], (DEPTH, D_SSM), 1.0)
    w_glu = nrm(ks[15], (DEPTH, D_SSM, D_SSM), D_SSM ** -0.5)
    b_glu = nrm(ks[16], (DEPTH, D_SSM), 0.01)
    conv_w = nrm(ks[17], (DEPTH, CONV_WIDTH, D_CONV), CONV_WIDTH ** -0.5)
    w_proj_ssm = nrm(ks[18], (DEPTH, D_SSM, D_MODEL), D_SSM ** -0.5)
    w_proj_conv = nrm(ks[19], (DEPTH, D_CONV, D_MODEL), D_CONV ** -0.5)
    w_out = nrm(ks[20], (DEPTH, D_MODEL, D_MODEL), D_MODEL ** -0.5)
    w_ff1 = nrm(ks[21], (DEPTH, D_MODEL, D_FF), D_MODEL ** -0.5)
    w_ff2 = nrm(ks[22], (DEPTH, D_FF, D_MODEL), D_FF ** -0.5)
    final_g = 1.0 + nrm(ks[23], (D_MODEL,), 0.02)
    return {"x": x, "c": c, "norm1_g": norm1_g, "norm2_g": norm2_g,
            "w_ada": w_ada, "b_ada": b_ada, "w_in": w_in,
            "lam_re": lam_re, "lam_im": lam_im, "log_dt": log_dt,
            "b_re": b_re, "b_im": b_im, "c_re": c_re, "c_im": c_im,
            "d_skip": d_skip, "w_glu": w_glu, "b_glu": b_glu, "conv_w": conv_w,
            "w_proj_ssm": w_proj_ssm, "w_proj_conv": w_proj_conv, "w_out": w_out,
            "w_ff1": w_ff1, "w_ff2": w_ff2, "final_g": final_g}


def reference(x, c, norm1_g, norm2_g, w_ada, b_ada, w_in, lam_re, lam_im, log_dt,
              b_re, b_im, c_re, c_im, d_skip, w_glu, b_glu, conv_w,
              w_proj_ssm, w_proj_conv, w_out, w_ff1, w_ff2, final_g):
    n_b, n_len, _ = x.shape
    split_at = [D_SSM, D_SSM + D_CONV, D_SSM + 2 * D_CONV, D_SSM + 3 * D_CONV,
                D_SSM + 3 * D_CONV + D_MODEL]
    c_act = jax.nn.silu(c)
    for l in range(DEPTH):
        mod = c_act @ w_ada[l] + b_ada[l]
        sh1, sc1, g1, sh2, sc2, g2 = jnp.split(mod, N_MOD, axis=-1)

        h = modulate(rmsnorm(x, norm1_g[l]), sh1, sc1)
        p = h @ w_in[l]
        u_s, cb, cc, cx, gate_s, gate_c = jnp.split(p, split_at, axis=-1)

        u_g = u_s.reshape(n_b, n_len, N_SSM_GROUPS, SSM_GROUP)
        y_s = s5_mimo(u_g, lam_re[l], lam_im[l], log_dt[l], b_re[l], b_im[l],
                      c_re[l], c_im[l], d_skip[l].reshape(N_SSM_GROUPS, SSM_GROUP))
        y_s = jax.nn.gelu(y_s.reshape(n_b, n_len, D_SSM))
        y_s = y_s * jax.nn.sigmoid(y_s @ w_glu[l] + b_glu[l])

        y_c = short_gated_conv(cx, cb, cc, conv_w[l])

        merged = (jax.nn.sigmoid(gate_s) * (y_s @ w_proj_ssm[l])
                  + jax.nn.sigmoid(gate_c) * (y_c @ w_proj_conv[l]))
        x = x + g1[:, None, :] * (merged @ w_out[l])

        h2 = modulate(rmsnorm(x, norm2_g[l]), sh2, sc2)
        f = jnp.square(jax.nn.relu(h2 @ w_ff1[l])) @ w_ff2[l]
        x = x + g2[:, None, :] * f
    return rmsnorm(x, final_g)
```

```cpp
#include <hip/hip_runtime.h>
#include <cstdio>
#include <cstdint>

namespace v1 {
constexpr int D = 1024, BATCH = 32, SEQ = 2048, M = BATCH * SEQ;
constexpr int DS = 512, DC = 512, DFF = 4096, INC = 4096, NMOD = 6;
constexpr int G = 32, H = 16, P = 64;
constexpr float EPS = 1e-6f;
constexpr int NCHUNK = 4, BPC = BATCH / NCHUNK, MC = BPC * SEQ;

__device__ __forceinline__ float sigmoidf_(float v) { return 1.f / (1.f + expf(-v)); }
__device__ __forceinline__ float gelu_tanh(float v) { const float k = 0.7978845608028654f; return 0.5f * v * (1.f + tanhf(k * (v + 0.044715f * v * v * v))); }

__global__ void __launch_bounds__(256) k_mod(const float* c, const float* w_ada, const float* b_ada, float* mod) {
    __shared__ float cs[D];
    const int b = blockIdx.y, j = blockIdx.x * 256 + threadIdx.x;
    for (int k = threadIdx.x; k < D; k += 256) { const float v = c[b * D + k]; cs[k] = v * sigmoidf_(v); }
    __syncthreads();
    float acc = 0.f;
    for (int k = 0; k < D; ++k) acc += cs[k] * w_ada[(size_t)k * (NMOD * D) + j];
    mod[b * (NMOD * D) + j] = acc + b_ada[j];
}

__global__ void __launch_bounds__(256) k_norm_mod(const float* in, const float* g, const float* mod, float* out, int sh_off, int sc_off, int m_base_global, int use_mod) {
    __shared__ float red[4];
    const int ml = blockIdx.x; const int mg = m_base_global + ml; const int b = mg / SEQ;
    const float* row = in + (size_t)ml * D;
    float v[4]; float s = 0.f;
#pragma unroll
    for (int i = 0; i < 4; ++i) { v[i] = row[threadIdx.x + 256 * i]; s += v[i] * v[i]; }
#pragma unroll
    for (int o = 32; o >= 1; o >>= 1) s += __shfl_xor(s, o);
    if ((threadIdx.x & 63) == 0) red[threadIdx.x >> 6] = s;
    __syncthreads();
    s = red[0] + red[1] + red[2] + red[3];
    const float r = rsqrtf(s / D + EPS);
#pragma unroll
    for (int i = 0; i < 4; ++i) { const int k = threadIdx.x + 256 * i; float y = v[i] * r * g[k];
        if (use_mod) y = y * (1.f + mod[b * (NMOD * D) + sc_off + k]) + mod[b * (NMOD * D) + sh_off + k];
        out[(size_t)ml * D + k] = y; }
}

template <class Epi>
__global__ void __launch_bounds__(256) k_gemm(const float* __restrict__ A, const float* __restrict__ W, Epi epi, int lda, int ldw, int K, int pad_) {
    __shared__ float As[16][132];
    __shared__ float Bs[16][128];
    const int tid = threadIdx.x, tx = tid & 15, ty = tid >> 4;
    const int m0 = blockIdx.y * 128, n0 = blockIdx.x * 128;
    float acc[8][8];
#pragma unroll
    for (int i = 0; i < 8; ++i)
#pragma unroll
        for (int j = 0; j < 8; ++j) acc[i][j] = 0.f;
    const int ar = tid >> 1, ak = (tid & 1) * 8;
    const int bk = tid >> 4, bn = (tid & 15) * 8;
    for (int k0 = 0; k0 < K; k0 += 16) {
        const float4 a0 = *(const float4*)(A + (size_t)(m0 + ar) * lda + k0 + ak);
        const float4 a1 = *(const float4*)(A + (size_t)(m0 + ar) * lda + k0 + ak + 4);
        const float4 b0 = *(const float4*)(W + (size_t)(k0 + bk) * ldw + n0 + bn);
        const float4 b1 = *(const float4*)(W + (size_t)(k0 + bk) * ldw + n0 + bn + 4);
        __syncthreads();
        As[ak + 0][ar] = a0.x; As[ak + 1][ar] = a0.y; As[ak + 2][ar] = a0.z; As[ak + 3][ar] = a0.w;
        As[ak + 4][ar] = a1.x; As[ak + 5][ar] = a1.y; As[ak + 6][ar] = a1.z; As[ak + 7][ar] = a1.w;
        *(float4*)&Bs[bk][bn] = b0; *(float4*)&Bs[bk][bn + 4] = b1;
        __syncthreads();
#pragma unroll
        for (int kk = 0; kk < 16; ++kk) {
            const float4 x0 = *(const float4*)&As[kk][ty * 8], x1 = *(const float4*)&As[kk][ty * 8 + 4];
            const float4 y0 = *(const float4*)&Bs[kk][tx * 8], y1 = *(const float4*)&Bs[kk][tx * 8 + 4];
            const float a[8] = {x0.x, x0.y, x0.z, x0.w, x1.x, x1.y, x1.z, x1.w};
            const float b[8] = {y0.x, y0.y, y0.z, y0.w, y1.x, y1.y, y1.z, y1.w};
#pragma unroll
            for (int i = 0; i < 8; ++i)
#pragma unroll
                for (int j = 0; j < 8; ++j) acc[i][j] += a[i] * b[j];
        }
    }
#pragma unroll
    for (int i = 0; i < 8; ++i)
#pragma unroll
        for (int j = 0; j < 8; ++j) epi(m0 + ty * 8 + i, n0 + tx * 8 + j, acc[i][j]);
}

struct EpiStore { float* C; int ldc; int pad; __device__ void operator()(int m, int n, float v) const { C[(size_t)m * ldc + n] = v; } };
struct EpiGlu { const float* YG; const float* bglu; float* YS; __device__ void operator()(int m, int n, float v) const { YS[(size_t)m * DS + n] = YG[(size_t)m * DS + n] * sigmoidf_(v + bglu[n]); } };
struct EpiGate { const float* Pm; float* MG; int goff; int accum; __device__ void operator()(int m, int n, float v) const {
    const float r = sigmoidf_(Pm[(size_t)m * INC + goff + n]) * v; float* o = MG + (size_t)m * D + n; *o = accum ? (*o + r) : r; } };
struct EpiRes { const float* base; const float* mod; float* out; int goff; int m_base_global; __device__ void operator()(int m, int n, float v) const {
    const int b = (m_base_global + m) / SEQ; out[(size_t)m * D + n] = base[(size_t)m * D + n] + mod[b * (NMOD * D) + goff + n] * v; } };
struct EpiRelu2 { float* Hd; __device__ void operator()(int m, int n, float v) const { const float r = v > 0.f ? v : 0.f; Hd[(size_t)m * DFF + n] = r * r; } };

__global__ void __launch_bounds__(64) k_ssm(const float* Pm, const float* lam_re, const float* lam_im, const float* log_dt, const float* b_re, const float* b_im,
                                            const float* c_re, const float* c_im, const float* d_skip, float* YG) {
    __shared__ float ss[2][64];
    const int g = blockIdx.x, bl = blockIdx.y, lane = threadIdx.x;
    const int p = lane;
    const float dt = expf(log_dt[g]);
    const float lr = lam_re[g * P + p], li = lam_im[g * P + p];
    const float er = expf(lr * dt); const float ar = er * cosf(li * dt), ai = er * sinf(li * dt);
    const float nr = ar - 1.f, ni = ai; const float den = lr * lr + li * li;
    const float qr = (nr * lr + ni * li) / den, qi = (ni * lr - nr * li) / den;
    float bbr[H], bbi[H];
#pragma unroll
    for (int h = 0; h < H; ++h) { const float br = b_re[(g * P + p) * H + h], bi = b_im[(g * P + p) * H + h]; bbr[h] = qr * br - qi * bi; bbi[h] = qr * bi + qi * br; }
    const int ho = lane >> 2, q = lane & 3;
    float cr[16], ci[16];
#pragma unroll
    for (int j = 0; j < 16; ++j) { cr[j] = c_re[(g * H + ho) * P + 16 * q + j]; ci[j] = c_im[(g * H + ho) * P + 16 * q + j]; }
    const float dsk = d_skip[g * H + ho];
    float sr = 0.f, si = 0.f;
    const float* up = Pm + (size_t)bl * SEQ * INC + g * H;
    float* yp = YG + (size_t)bl * SEQ * DS + g * H;
    for (int t = 0; t < SEQ; ++t) {
        const float4* u4 = (const float4*)(up + (size_t)t * INC);
        const float4 u0 = u4[0], u1 = u4[1], u2 = u4[2], u3 = u4[3];
        const float u[16] = {u0.x, u0.y, u0.z, u0.w, u1.x, u1.y, u1.z, u1.w, u2.x, u2.y, u2.z, u2.w, u3.x, u3.y, u3.z, u3.w};
        float br = 0.f, bi = 0.f;
#pragma unroll
        for (int h = 0; h < H; ++h) { br += bbr[h] * u[h]; bi += bbi[h] * u[h]; }
        const float nsr = ar * sr - ai * si + br, nsi = ar * si + ai * sr + bi; sr = nsr; si = nsi;
        __syncthreads();
        ss[0][p] = sr; ss[1][p] = si;
        __syncthreads();
        float y = 0.f;
#pragma unroll
        for (int j = 0; j < 16; ++j) y += cr[j] * ss[0][16 * q + j] - ci[j] * ss[1][16 * q + j];
        y += __shfl_xor(y, 1); y += __shfl_xor(y, 2);
        float uh = 0.f;
#pragma unroll
        for (int h = 0; h < H; ++h) uh = (h == ho) ? u[h] : uh;
        y += dsk * uh;
        if (q == 0) yp[(size_t)t * DS + ho] = gelu_tanh(y);
    }
}

__global__ void __launch_bounds__(256) k_conv(const float* Pm, const float* conv_w, float* YC) {
    const size_t idx = (size_t)blockIdx.x * 256 + threadIdx.x;
    const int c = (int)(idx % DC); const int ml = (int)(idx / DC); const int t = ml % SEQ;
    const float* pr = Pm + (size_t)ml * INC;
    const float cb = pr[DS + c];
    float acc = conv_w[2 * DC + c] * (pr[DS + DC + c] * pr[DS + 2 * DC + c]);
    if (t >= 1) acc += conv_w[1 * DC + c] * (pr[-INC + DS + DC + c] * pr[-INC + DS + 2 * DC + c]);
    if (t >= 2) acc += conv_w[0 * DC + c] * (pr[-2 * INC + DS + DC + c] * pr[-2 * INC + DS + 2 * DC + c]);
    YC[idx] = cb * acc;
}
}

extern "C" void kernel_launch(void* const* d_in, const int* in_sizes, int n_in, void* d_out, int out_size, void* d_ws, size_t ws_size, hipStream_t stream) {
    using namespace v1;
    const float* x = (const float*)d_in[0]; const float* c = (const float*)d_in[1]; const float* norm1_g = (const float*)d_in[2]; const float* norm2_g = (const float*)d_in[3];
    const float* w_ada = (const float*)d_in[4]; const float* b_ada = (const float*)d_in[5]; const float* w_in = (const float*)d_in[6];
    const float* lam_re = (const float*)d_in[7]; const float* lam_im = (const float*)d_in[8]; const float* log_dt = (const float*)d_in[9];
    const float* b_re = (const float*)d_in[10]; const float* b_im = (const float*)d_in[11]; const float* c_re = (const float*)d_in[12]; const float* c_im = (const float*)d_in[13];
    const float* d_skip = (const float*)d_in[14]; const float* w_glu = (const float*)d_in[15]; const float* b_glu = (const float*)d_in[16]; const float* conv_w = (const float*)d_in[17];
    const float* w_proj_ssm = (const float*)d_in[18]; const float* w_proj_conv = (const float*)d_in[19]; const float* w_out = (const float*)d_in[20];
    const float* w_ff1 = (const float*)d_in[21]; const float* w_ff2 = (const float*)d_in[22]; const float* final_g = (const float*)d_in[23];
    float* out = (float*)d_out;
    const size_t MiB = 1u << 20;
    char* ws = (char*)d_ws;
    float* mod = (float*)(ws);
    float* Hb  = (float*)(ws + 1 * MiB);
    float* Pm  = (float*)(ws + 65 * MiB);
    float* YG  = (float*)(ws + 321 * MiB);
    float* YS  = (float*)(ws + 353 * MiB);
    float* YC  = (float*)(ws + 385 * MiB);
    float* MG  = (float*)(ws + 417 * MiB);
    float* X1  = (float*)(ws + 481 * MiB);
    if (ws_size < 545 * MiB) { fprintf(stderr, "ws too small\n"); return; }

    k_mod<<<dim3(NMOD * D / 256, BATCH), 256, 0, stream>>>(c, w_ada, b_ada, mod);
    for (int ch = 0; ch < NCHUNK; ++ch) {
        const int mb = ch * MC; const float* xc = x + (size_t)mb * D; float* oc = out + (size_t)mb * D;
        k_norm_mod<<<MC, 256, 0, stream>>>(xc, norm1_g, mod, Hb, 0, D, mb, 1);
        k_gemm<EpiStore><<<dim3(INC / 128, MC / 128), 256, 0, stream>>>(Hb, w_in, EpiStore{Pm, INC, 0}, D, INC, D, 0);
        k_ssm<<<dim3(G, BPC), 64, 0, stream>>>(Pm, lam_re, lam_im, log_dt, b_re, b_im, c_re, c_im, d_skip, YG);
        k_gemm<EpiGlu><<<dim3(DS / 128, MC / 128), 256, 0, stream>>>(YG, w_glu, EpiGlu{YG, b_glu, YS}, DS, DS, DS, 0);
        k_conv<<<(unsigned)((size_t)MC * DC / 256), 256, 0, stream>>>(Pm, conv_w, YC);
        k_gemm<EpiGate><<<dim3(D / 128, MC / 128), 256, 0, stream>>>(YS, w_proj_ssm, EpiGate{Pm, MG, DS + 3 * DC, 0}, DS, D, DS, 0);
        k_gemm<EpiGate><<<dim3(D / 128, MC / 128), 256, 0, stream>>>(YC, w_proj_conv, EpiGate{Pm, MG, DS + 3 * DC + D, 1}, DC, D, DC, 0);
        k_gemm<EpiRes><<<dim3(D / 128, MC / 128), 256, 0, stream>>>(MG, w_out, EpiRes{xc, mod, X1, 2 * D, mb}, D, D, D, 0);
        k_norm_mod<<<MC, 256, 0, stream>>>(X1, norm2_g, mod, Hb, 3 * D, 4 * D, mb, 1);
        k_gemm<EpiRelu2><<<dim3(DFF / 128, MC / 128), 256, 0, stream>>>(Hb, w_ff1, EpiRelu2{Pm}, D, DFF, D, 0);
        k_gemm<EpiRes><<<dim3(D / 128, MC / 128), 256, 0, stream>>>(Pm, w_ff2, EpiRes{X1, mod, X1, 5 * D, mb}, DFF, D, DFF, 0);
        k_norm_mod<<<MC, 256, 0, stream>>>(X1, final_g, mod, oc, 0, 0, mb, 0);
    }
}
```

```cpp
#include <hip/hip_runtime.h>
#include <cstdio>
#include <cstdint>

#define LAS __attribute__((address_space(3)))
#define GAS __attribute__((address_space(1)))
typedef unsigned short bf16_t;
typedef short bf16x8 __attribute__((ext_vector_type(8)));
typedef float f32x4 __attribute__((ext_vector_type(4)));
typedef float f32x2 __attribute__((ext_vector_type(2)));
typedef unsigned u32x4 __attribute__((ext_vector_type(4)));
typedef unsigned u32x2 __attribute__((ext_vector_type(2)));

#ifndef MK_N_LAUNCHES
#define MK_N_LAUNCHES 1
#endif
#ifndef PH_MASK
#define PH_MASK 0xFFFF
#endif

constexpr int D = 1024, BATCH = 32, SEQ = 2048, M = BATCH * SEQ, NPANEL = M / 256;
constexpr int DS = 512, DC = 512, DFF = 4096, INC = 4096, NMOD = 6;
constexpr int NG = 32, NH = 16, NP = 64, CT = 16, NCH = SEQ / CT;
constexpr float RMS_EPS = 1e-6f;

constexpr size_t MiB = 1u << 20;
constexpr size_t WS_CTL = 0, CTL_ZERO_BYTES = 1 * MiB;
constexpr size_t WS_MOD = 1 * MiB;
constexpr size_t WS_WIN = 2 * MiB;
constexpr size_t WS_WGLU = 10 * MiB;
constexpr size_t WS_PSSM = 11 * MiB;
constexpr size_t WS_PCONV = 12 * MiB;
constexpr size_t WS_WOUT = 13 * MiB;
constexpr size_t WS_W1 = 15 * MiB;
constexpr size_t WS_W2 = 23 * MiB;
constexpr size_t WS_BT1 = 31 * MiB;
constexpr size_t WS_BT2 = 33 * MiB;
constexpr size_t WS_L16 = 41 * MiB;
constexpr size_t WS_HN = 48 * MiB;
constexpr size_t WS_U = 176 * MiB;
constexpr size_t WS_CB = 240 * MiB;
constexpr size_t WS_V = 304 * MiB;
constexpr size_t WS_YG = 368 * MiB;
constexpr size_t WS_PANEL = 432 * MiB;
constexpr size_t PANEL_BYTES = 2 * MiB, PL_GS = 0, PL_GC = 512 * 1024, PL_MG = 1024 * 1024, PL_YS = 1536 * 1024, PL_YC = 1792 * 1024;
constexpr size_t WS_END = 944 * MiB;
constexpr int CW_TMO = 0, CW_BAR = 4096;

constexpr int RING_BYTES = 131072;
constexpr int MISC_OFF = 143360;
constexpr int LDS_BYTES = 147456;
constexpr int SSM_SOFF = 65536;
constexpr int NWAVES = 8;

#define RLX_AGENT __ATOMIC_RELAXED, __HIP_MEMORY_SCOPE_AGENT
#define LDS_WAIT() asm volatile("s_waitcnt lgkmcnt(0)" ::: "memory")
#define VM_WAIT() asm volatile("s_waitcnt vmcnt(0)" ::: "memory")

__device__ __forceinline__ unsigned f2bf(float f) { unsigned u = __builtin_bit_cast(unsigned, f); return (u + 0x7fffu + ((u >> 16) & 1u)) >> 16; }
__device__ __forceinline__ unsigned pk2(float lo, float hi) { return f2bf(lo) | (f2bf(hi) << 16); }
__device__ __forceinline__ unsigned cvt_pk_bf16(float lo, float hi) { unsigned r; asm volatile("v_cvt_pk_bf16_f32 %0, %1, %2" : "=v"(r) : "v"(lo), "v"(hi)); return r; }
__device__ __forceinline__ float bf_lo(unsigned w) { return __uint_as_float(w << 16); }
__device__ __forceinline__ float bf_hi(unsigned w) { return __uint_as_float(w & 0xffff0000u); }
__device__ __forceinline__ float fsigmoid(float v) { return __builtin_amdgcn_rcpf(1.0f + __expf(-v)); }
__device__ __forceinline__ float gelu_tanh(float v) { const float u = 0.7978845608028654f * (v + 0.044715f * v * v * v); return v * __builtin_amdgcn_rcpf(1.0f + __expf(-2.0f * u)); }
__device__ __forceinline__ float wave_sum(float v) {
#pragma unroll
    for (int o = 1; o < 64; o <<= 1) v += __shfl_xor(v, o);
    return v;
}

namespace pg8 {
constexpr int BM = 256, BK = 64, HALF = 128, HTB = HALF * BK * 2, STAGE_BYTES = 8 * HTB;
__device__ __forceinline__ int lds_byte(int r, int c) { const int st = (r >> 4) * 2 + (c >> 5), rr = r & 15, cc = c & 31, ob = rr * 64 + cc * 2; return st * 1024 + (ob ^ (((ob >> 9) & 1) << 5)); }
__device__ __forceinline__ void stage_rc(int b, int& R, int& C) { const int st = b / 1024, sb = b % 1024, swz = sb ^ (((sb >> 9) & 1) << 5); R = (st >> 1) * 16 + swz / 64; C = (st & 1) * 32 + (swz % 64) / 2; }
__device__ __forceinline__ int perm32(int rho) { const int n = rho >> 4, i = rho & 15; return 8 * (i >> 2) + 4 * n + (i & 3); }

struct UnitD { const char* A; const char* B; int pn; int part; };

template <class Epi, class Sched, bool ALIGN_EPI, bool SP2>
__device__ __forceinline__ void gemm_phase(LAS unsigned char* lds, const int K, const Sched& S, const Epi& E) {
    int tid_ = threadIdx.x; asm volatile("" : "+v"(tid_));
    const int tid = tid_, wid = __builtin_amdgcn_readfirstlane(tid >> 6), lane = tid & 63, wr = wid >> 2, wc = wid & 3, fr = lane & 15, fq = lane >> 4;
    const int nt = K / BK;
    unsigned voffA[2], voffB[2];
#pragma unroll
    for (int i = 0; i < 2; ++i) { int R, C; stage_rc(tid * 16 + i * 8192, R, C); const int Rb = Epi::PERM ? ((R & ~31) + perm32(R & 31)) : R;
        voffA[i] = (unsigned)(R * K + C) * 2u; voffB[i] = (unsigned)(Rb * K + C) * 2u; }
    const size_t kstep = (size_t)(BK * 2);
    const size_t hstep = (size_t)HALF * K * 2;
    const unsigned ldsw = (unsigned)wid * 1024u;
    const int aoff = lds_byte(wr * 64 + fr, fq * 8), boff = lds_byte(wc * 32 + fr, fq * 8);
#define PG8_SA(b, h) (((b) * 2 + (h)) * HTB)
#define PG8_SB(b, h) ((4 + (b) * 2 + (h)) * HTB)
#define PG8_STAGE(bufoff, gbase, voff) do { _Pragma("unroll") for (int _i = 0; _i < 2; ++_i) \
        __builtin_amdgcn_global_load_lds((const unsigned*)((const char*)(gbase) + (voff)[_i]), (LAS unsigned*)(lds + (bufoff) + ldsw + _i * 8192), 16, 0, 0); } while (0)
#define PG8_LDA(dst, b, h) do { _Pragma("unroll") for (int m = 0; m < 4; ++m) _Pragma("unroll") for (int k = 0; k < 2; ++k) dst[m][k] = *(const LAS bf16x8*)(lds + PG8_SA(b, h) + aoff + m * 2048 + k * 1024); } while (0)
#define PG8_LDB(dst, b, h) do { _Pragma("unroll") for (int n = 0; n < 2; ++n) _Pragma("unroll") for (int k = 0; k < 2; ++k) dst[n][k] = *(const LAS bf16x8*)(lds + PG8_SB(b, h) + boff + n * 2048 + k * 1024); } while (0)
#define PG8_MMA(ai, bj, At, Bt) do { __builtin_amdgcn_s_setprio(1); _Pragma("unroll") for (int m = 0; m < 4; ++m) _Pragma("unroll") for (int n = 0; n < 2; ++n) _Pragma("unroll") for (int k = 0; k < 2; ++k) \
        acc[ai][bj][m][n] = __builtin_amdgcn_mfma_f32_16x16x32_bf16(Bt[n][k], At[m][k], acc[ai][bj][m][n], 0, 0, 0); __builtin_amdgcn_s_setprio(0); } while (0)
#define PG8_WAIT_V(n) asm volatile("s_waitcnt vmcnt(" #n ")" ::: "memory")
#define PG8_WAIT_L(n) asm volatile("s_waitcnt lgkmcnt(" #n ")" ::: "memory")
#define PG8_BAR __builtin_amdgcn_s_barrier()
#define PG8_SCHED __builtin_amdgcn_sched_barrier(0)
    UnitD cur, nxt; int ui = 0;
    if (!S.next(0, cur)) return;
    f32x4 acc[2][2][4][2];
#pragma unroll
    for (int a = 0; a < 2; ++a)
#pragma unroll
        for (int b = 0; b < 2; ++b)
#pragma unroll
            for (int m = 0; m < 4; ++m)
#pragma unroll
                for (int n = 0; n < 2; ++n) acc[a][b][m][n] = (f32x4){0.f, 0.f, 0.f, 0.f};
    bf16x8 At[4][2], B0[2][2], B1[2][2];
    const char* cA = cur.A; const char* cB = cur.B;
    if constexpr (SP2) {
        PG8_STAGE(PG8_SB(0, 0), cB, voffB); PG8_STAGE(PG8_SB(0, 1), cB + hstep, voffB); PG8_STAGE(PG8_SA(0, 0), cA, voffA); PG8_STAGE(PG8_SA(0, 1), cA + hstep, voffA);
        if (wr == 1) PG8_BAR;
        PG8_WAIT_V(2); PG8_BAR;
        PG8_STAGE(PG8_SB(1, 0), cB + kstep, voffB); PG8_STAGE(PG8_SA(1, 0), cA + kstep, voffA); PG8_STAGE(PG8_SB(1, 1), cB + hstep + kstep, voffB);
        PG8_WAIT_V(6); PG8_BAR;
    } else {
        PG8_STAGE(PG8_SB(0, 0), cB, voffB); PG8_STAGE(PG8_SA(0, 0), cA, voffA); PG8_STAGE(PG8_SB(0, 1), cB + hstep, voffB); PG8_STAGE(PG8_SA(0, 1), cA + hstep, voffA);
        if (wr == 1) PG8_BAR;
        PG8_WAIT_V(4); PG8_BAR;
        PG8_STAGE(PG8_SB(1, 0), cB + kstep, voffB); PG8_STAGE(PG8_SA(1, 0), cA + kstep, voffA); PG8_STAGE(PG8_SB(1, 1), cB + hstep + kstep, voffB);
        PG8_WAIT_V(6); PG8_BAR;
    }
    for (;;) {
        const bool has_next = S.next(ui + 1, nxt);
        const char* nA = has_next ? nxt.A : cA; const char* nB = has_next ? nxt.B : cB;
        for (int t = 0; t < nt; t += 2) {
            const bool last = (t == nt - 2);
            const char* a1 = cA + (size_t)(t + 1) * kstep;
            const char* a2 = last ? nA : cA + (size_t)(t + 2) * kstep; const char* b2 = last ? nB : cB + (size_t)(t + 2) * kstep;
            const char* a3 = a2 + kstep; const char* b3 = b2 + kstep;
            if constexpr (SP2) {
            PG8_LDB(B0, 0, 0); PG8_LDB(B1, 0, 1); PG8_SCHED; PG8_LDA(At, 0, 0); PG8_STAGE(PG8_SA(1, 1), a1 + hstep, voffA);
            PG8_WAIT_V(8); PG8_WAIT_L(0); PG8_BAR; PG8_MMA(0, 0, At, B0); PG8_MMA(0, 1, At, B1); PG8_BAR; PG8_SCHED;
            PG8_LDA(At, 0, 1); PG8_STAGE(PG8_SB(0, 0), b2, voffB); PG8_STAGE(PG8_SB(0, 1), b2 + hstep, voffB); PG8_STAGE(PG8_SA(0, 0), a2, voffA);
            PG8_WAIT_V(8); PG8_WAIT_L(0); PG8_BAR; PG8_MMA(1, 0, At, B0); PG8_MMA(1, 1, At, B1); PG8_BAR; PG8_SCHED;
            PG8_LDB(B0, 1, 0); PG8_LDB(B1, 1, 1); PG8_SCHED; PG8_LDA(At, 1, 0); PG8_STAGE(PG8_SA(0, 1), a2 + hstep, voffA);
            PG8_WAIT_V(8); PG8_WAIT_L(0); PG8_BAR; PG8_MMA(0, 0, At, B0); PG8_MMA(0, 1, At, B1); PG8_BAR; PG8_SCHED;
            PG8_LDA(At, 1, 1); PG8_STAGE(PG8_SB(1, 0), b3, voffB); PG8_STAGE(PG8_SB(1, 1), b3 + hstep, voffB); PG8_STAGE(PG8_SA(1, 0), a3, voffA);
            PG8_WAIT_V(8); PG8_WAIT_L(0); PG8_BAR; PG8_MMA(1, 0, At, B0); PG8_MMA(1, 1, At, B1); PG8_BAR; PG8_SCHED;
            } else {
            PG8_LDB(B0, 0, 0); PG8_SCHED; PG8_LDA(At, 0, 0); PG8_STAGE(PG8_SA(1, 1), a1 + hstep, voffA);
            PG8_WAIT_L(8); PG8_BAR; PG8_WAIT_L(0); PG8_MMA(0, 0, At, B0); PG8_BAR; PG8_SCHED;
            PG8_LDB(B1, 0, 1); PG8_STAGE(PG8_SB(0, 0), b2, voffB);
            PG8_BAR; PG8_WAIT_L(0); PG8_MMA(0, 1, At, B1); PG8_BAR;
            PG8_LDA(At, 0, 1); PG8_STAGE(PG8_SA(0, 0), a2, voffA);
            PG8_BAR; PG8_WAIT_L(0); PG8_MMA(1, 0, At, B0); PG8_BAR; PG8_SCHED;
            PG8_STAGE(PG8_SB(0, 1), b2 + hstep, voffB);
            PG8_WAIT_V(6); PG8_BAR; PG8_MMA(1, 1, At, B1); PG8_BAR;
            PG8_LDB(B0, 1, 0); PG8_SCHED; PG8_LDA(At, 1, 0); PG8_STAGE(PG8_SA(0, 1), a2 + hstep, voffA);
            PG8_WAIT_L(8); PG8_BAR; PG8_WAIT_L(0); PG8_MMA(0, 0, At, B0); PG8_BAR; PG8_SCHED;
            PG8_LDB(B1, 1, 1); PG8_STAGE(PG8_SB(1, 0), b3, voffB);
            PG8_BAR; PG8_WAIT_L(0); PG8_MMA(0, 1, At, B1); PG8_BAR;
            PG8_LDA(At, 1, 1); PG8_STAGE(PG8_SA(1, 0), a3, voffA);
            PG8_BAR; PG8_WAIT_L(0); PG8_MMA(1, 0, At, B0); PG8_BAR; PG8_SCHED;
            PG8_STAGE(PG8_SB(1, 1), b3 + hstep, voffB);
            PG8_WAIT_V(6); PG8_BAR; PG8_MMA(1, 1, At, B1); PG8_BAR;
            }
        }
        if constexpr (ALIGN_EPI) { if (wr == 0) PG8_BAR; }
        const bool zero = E(acc, cur, wr, wc, fr, fq);
        if (!has_next) break;
        if (zero) {
#pragma unroll
        for (int a = 0; a < 2; ++a)
#pragma unroll
            for (int b = 0; b < 2; ++b)
#pragma unroll
                for (int m = 0; m < 4; ++m)
#pragma unroll
                    for (int n = 0; n < 2; ++n) acc[a][b][m][n] = (f32x4){0.f, 0.f, 0.f, 0.f};
        }
        cur = nxt; cA = nA; cB = nB; ++ui;
        if constexpr (ALIGN_EPI) { if (wr == 1) PG8_BAR; }
    }
    PG8_WAIT_V(0);
    if constexpr (!ALIGN_EPI) { if (wr == 0) PG8_BAR; }
    PG8_BAR;
#undef PG8_SA
#undef PG8_SB
#undef PG8_STAGE
#undef PG8_LDA
#undef PG8_LDB
#undef PG8_MMA
#undef PG8_WAIT_V
#undef PG8_WAIT_L
#undef PG8_BAR
#undef PG8_SCHED
}
}
using pg8::UnitD;

struct SchedCols { const char* A; const char* B; size_t bstep; int ntiles;
    __device__ __forceinline__ bool next(int i, UnitD& u) const { if (i >= ntiles) return false; u.A = A; u.B = B + (size_t)i * bstep; u.pn = i; u.part = 0; return true; } };
struct SchedMerge { const char* A0; const char* A1; const char* B0; const char* B1; size_t bstep;
    __device__ __forceinline__ bool next(int i, UnitD& u) const { if (i >= 8) return false; const int p = i & 1; u.A = p ? A1 : A0; u.B = (p ? B1 : B0) + (size_t)(i >> 1) * bstep; u.pn = i >> 1; u.part = p; return true; } };

#define EPI_ROWS for (int ai = 0; ai < 2; ++ai) _Pragma("unroll") for (int m = 0; m < 4; ++m)
struct EpiIn { static constexpr bool PERM = true;
    bf16_t* U; bf16_t* CB; bf16_t* V; bf16_t* GS; bf16_t* GC; int row0;
    __device__ __forceinline__ bool operator()(f32x4 (&acc)[2][2][4][2], const UnitD& u, int wr, int wc, int fr, int fq) const {
        asm volatile("" : "+v"(fr), "+v"(fq));
        const int pn = u.pn, cb8 = wc * 32 + 8 * fq;
        if (pn < 2) {
#pragma unroll
            EPI_ROWS { const int rowl = ai * 128 + wr * 64 + m * 16 + fr;
#pragma unroll
                for (int bj = 0; bj < 2; ++bj) { const int c = pn * 256 + bj * 128 + cb8; const f32x4 v0 = acc[ai][bj][m][0], v1 = acc[ai][bj][m][1];
                    u32x4 w; w.x = cvt_pk_bf16(v0[0], v0[1]); w.y = cvt_pk_bf16(v0[2], v0[3]); w.z = cvt_pk_bf16(v1[0], v1[1]); w.w = cvt_pk_bf16(v1[2], v1[3]);
                    *(u32x4*)(U + ((size_t)(c >> 4) * M + (size_t)(row0 + rowl)) * 16 + (c & 15)) = w; } }
        } else if (pn < 4) {
#pragma unroll
            EPI_ROWS { const int rowl = ai * 128 + wr * 64 + m * 16 + fr;
#pragma unroll
                for (int bj = 0; bj < 2; ++bj) { const int c = (pn - 2) * 256 + bj * 128 + cb8; const f32x4 v0 = acc[ai][bj][m][0], v1 = acc[ai][bj][m][1];
                    u32x4 w; w.x = cvt_pk_bf16(v0[0], v0[1]); w.y = cvt_pk_bf16(v0[2], v0[3]); w.z = cvt_pk_bf16(v1[0], v1[1]); w.w = cvt_pk_bf16(v1[2], v1[3]);
                    *(u32x4*)(CB + (size_t)(row0 + rowl) * DC + c) = w; } }
        } else if (pn < 8) {
#pragma unroll
            EPI_ROWS { const int rowl = ai * 128 + wr * 64 + m * 16 + fr; const int c = (pn - 4) * 128 + cb8;
                const f32x4 v0 = acc[ai][0][m][0] * acc[ai][1][m][0], v1 = acc[ai][0][m][1] * acc[ai][1][m][1];
                u32x4 w; w.x = cvt_pk_bf16(v0[0], v0[1]); w.y = cvt_pk_bf16(v0[2], v0[3]); w.z = cvt_pk_bf16(v1[0], v1[1]); w.w = cvt_pk_bf16(v1[2], v1[3]);
                *(u32x4*)(V + (size_t)(row0 + rowl) * DC + c) = w; }
        } else {
            bf16_t* dst = pn < 12 ? GS : GC; const float lo = pn < 12 ? 0.f : 1e-9f;
#pragma unroll
            EPI_ROWS { const int rowl = ai * 128 + wr * 64 + m * 16 + fr;
#pragma unroll
                for (int bj = 0; bj < 2; ++bj) { const int c = ((pn - 8) & 3) * 256 + bj * 128 + cb8; f32x4 v0 = acc[ai][bj][m][0], v1 = acc[ai][bj][m][1];
#pragma unroll
                    for (int j = 0; j < 4; ++j) { v0[j] = fmaxf(fsigmoid(v0[j]), lo); v1[j] = fmaxf(fsigmoid(v1[j]), lo); }
                    u32x4 w; w.x = cvt_pk_bf16(v0[0], v0[1]); w.y = cvt_pk_bf16(v0[2], v0[3]); w.z = cvt_pk_bf16(v1[0], v1[1]); w.w = cvt_pk_bf16(v1[2], v1[3]);
                    *(u32x4*)(dst + (size_t)rowl * D + c) = w; } }
        }
        return true;
    }
};
struct EpiGlu { static constexpr bool PERM = true;
    const bf16_t* YG; const float* bglu; bf16_t* YS; int row0;
    __device__ __forceinline__ bool operator()(f32x4 (&acc)[2][2][4][2], const UnitD& u, int wr, int wc, int fr, int fq) const {
        asm volatile("" : "+v"(fr), "+v"(fq));
        const int cb8 = wc * 32 + 8 * fq;
#pragma unroll
        for (int bj = 0; bj < 2; ++bj) { const int c = u.pn * 256 + bj * 128 + cb8; const f32x4 b0 = *(const f32x4*)(bglu + c), b1 = *(const f32x4*)(bglu + c + 4);
#pragma unroll
            EPI_ROWS { const int rowl = ai * 128 + wr * 64 + m * 16 + fr;
                const u32x4 y = *(const u32x4*)(YG + (size_t)(row0 + rowl) * DS + c); const f32x4 z0 = acc[ai][bj][m][0] + b0, z1 = acc[ai][bj][m][1] + b1;
                u32x4 w; w.x = cvt_pk_bf16(bf_lo(y.x) * fsigmoid(z0[0]), bf_hi(y.x) * fsigmoid(z0[1])); w.y = cvt_pk_bf16(bf_lo(y.y) * fsigmoid(z0[2]), bf_hi(y.y) * fsigmoid(z0[3]));
                w.z = cvt_pk_bf16(bf_lo(y.z) * fsigmoid(z1[0]), bf_hi(y.z) * fsigmoid(z1[1])); w.w = cvt_pk_bf16(bf_lo(y.w) * fsigmoid(z1[2]), bf_hi(y.w) * fsigmoid(z1[3]));
                *(u32x4*)(YS + (size_t)rowl * DS + c) = w; } }
        return true;
    }
};
struct EpiMerge { static constexpr bool PERM = true;
    const bf16_t* GS; const bf16_t* GC; bf16_t* MG;
    __device__ __forceinline__ bool operator()(f32x4 (&acc)[2][2][4][2], const UnitD& u, int wr, int wc, int fr, int fq) const {
        asm volatile("" : "+v"(fr), "+v"(fq));
        const int cb8 = wc * 32 + 8 * fq;
        if (u.part == 0) {
#pragma unroll
            EPI_ROWS { const int rowl = ai * 128 + wr * 64 + m * 16 + fr;
#pragma unroll
                for (int bj = 0; bj < 2; ++bj) { const int c = u.pn * 256 + bj * 128 + cb8;
                    const u32x4 a = *(const u32x4*)(GS + (size_t)rowl * D + c), b = *(const u32x4*)(GC + (size_t)rowl * D + c);
                    f32x4 r0, r1;
                    r0[0] = bf_lo(a.x) * __builtin_amdgcn_rcpf(bf_lo(b.x)); r0[1] = bf_hi(a.x) * __builtin_amdgcn_rcpf(bf_hi(b.x)); r0[2] = bf_lo(a.y) * __builtin_amdgcn_rcpf(bf_lo(b.y)); r0[3] = bf_hi(a.y) * __builtin_amdgcn_rcpf(bf_hi(b.y));
                    r1[0] = bf_lo(a.z) * __builtin_amdgcn_rcpf(bf_lo(b.z)); r1[1] = bf_hi(a.z) * __builtin_amdgcn_rcpf(bf_hi(b.z)); r1[2] = bf_lo(a.w) * __builtin_amdgcn_rcpf(bf_lo(b.w)); r1[3] = bf_hi(a.w) * __builtin_amdgcn_rcpf(bf_hi(b.w));
                    acc[ai][bj][m][0] *= r0; acc[ai][bj][m][1] *= r1; } }
            return false;
        }
#pragma unroll
        EPI_ROWS { const int rowl = ai * 128 + wr * 64 + m * 16 + fr;
#pragma unroll
            for (int bj = 0; bj < 2; ++bj) { const int c = u.pn * 256 + bj * 128 + cb8; const u32x4 b = *(const u32x4*)(GC + (size_t)rowl * D + c);
                const f32x4 v0 = acc[ai][bj][m][0], v1 = acc[ai][bj][m][1];
                u32x4 w; w.x = cvt_pk_bf16(v0[0] * bf_lo(b.x), v0[1] * bf_hi(b.x)); w.y = cvt_pk_bf16(v0[2] * bf_lo(b.y), v0[3] * bf_hi(b.y));
                w.z = cvt_pk_bf16(v1[0] * bf_lo(b.z), v1[1] * bf_hi(b.z)); w.w = cvt_pk_bf16(v1[2] * bf_lo(b.w), v1[3] * bf_hi(b.w));
                *(u32x4*)(MG + (size_t)rowl * D + c) = w; } }
        return true;
    }
};
struct EpiRes { static constexpr bool PERM = false;
    const float* base; const float* gate; float* out;
    __device__ __forceinline__ bool operator()(f32x4 (&acc)[2][2][4][2], const UnitD& u, int wr, int wc, int fr, int fq) const {
        asm volatile("" : "+v"(fr), "+v"(fq));
        const int col0 = u.pn * 256 + wc * 32 + 4 * fq;
        f32x4 gv[2][2];
#pragma unroll
        for (int bj = 0; bj < 2; ++bj)
#pragma unroll
            for (int n = 0; n < 2; ++n) gv[bj][n] = *(const f32x4*)(gate + col0 + bj * 128 + n * 16);
#pragma unroll
        EPI_ROWS { const size_t off = (size_t)(ai * 128 + wr * 64 + m * 16 + fr) * D + col0;
#pragma unroll
            for (int bj = 0; bj < 2; ++bj)
#pragma unroll
                for (int n = 0; n < 2; ++n) { const f32x4 bs = *(const f32x4*)(base + off + bj * 128 + n * 16); *(f32x4*)(out + off + bj * 128 + n * 16) = bs + gv[bj][n] * acc[ai][bj][m][n]; }
            asm volatile("" ::: "memory"); }
        return true;
    }
};
struct EpiRelu2 { static constexpr bool PERM = true;
    bf16_t* HID;
    __device__ __forceinline__ bool operator()(f32x4 (&acc)[2][2][4][2], const UnitD& u, int wr, int wc, int fr, int fq) const {
        asm volatile("" : "+v"(fr), "+v"(fq));
        const int cb8 = wc * 32 + 8 * fq;
#pragma unroll
        EPI_ROWS { const int rowl = ai * 128 + wr * 64 + m * 16 + fr;
#pragma unroll
            for (int bj = 0; bj < 2; ++bj) { const int c = u.pn * 256 + bj * 128 + cb8; f32x4 v0 = acc[ai][bj][m][0], v1 = acc[ai][bj][m][1];
#pragma unroll
                for (int j = 0; j < 4; ++j) { const float a = fmaxf(v0[j], 0.f), b = fmaxf(v1[j], 0.f); v0[j] = a * a; v1[j] = b * b; }
                u32x4 w; w.x = cvt_pk_bf16(v0[0], v0[1]); w.y = cvt_pk_bf16(v0[2], v0[3]); w.z = cvt_pk_bf16(v1[0], v1[1]); w.w = cvt_pk_bf16(v1[2], v1[3]);
                *(u32x4*)(HID + (size_t)rowl * DFF + c) = w; } }
        return true;
    }
};

#define XB_TMO      128
#define XB_XCNT(j)  (256  + 64 * (j))
#define XB_XSUB(j)  (1280 + 64 * (j))
#define XB_XGEN(j)  (2304 + 64 * (j))
#define XB_TOP      3328
#define XB_TOPGEN   3392
#define XCD_BAR_WORDS 3456
#define XB_SPIN_CAP (1u << 18)
__device__ __forceinline__ unsigned xb_ld(unsigned* p)              { return __hip_atomic_load(p, __ATOMIC_RELAXED, __HIP_MEMORY_SCOPE_AGENT); }
__device__ __forceinline__ unsigned xb_add(unsigned* p, unsigned v) { return __hip_atomic_fetch_add(p, v, __ATOMIC_RELAXED, __HIP_MEMORY_SCOPE_AGENT); }
__device__ __forceinline__ unsigned xb_xcc_id() { return (unsigned)__builtin_amdgcn_s_getreg((3 << 11) | 20) & 0xFu; }
#define XB_SPIN(cond, bar) do { unsigned _sp = 0; while (cond) { __builtin_amdgcn_s_sleep(1); \
    if ((++_sp & 255u) == 0u) { if (xb_ld(&(bar)[XB_TMO])) break; if (_sp > XB_SPIN_CAP) { atomicAdd(&(bar)[XB_TMO], 1u); break; } } } } while (0)
struct XcdBarrier { unsigned* bar; unsigned x; volatile LAS unsigned* st; };
__device__ __forceinline__ XcdBarrier xcd_barrier_post(unsigned* bar, volatile LAS unsigned* st) {
    XcdBarrier b; b.bar = bar; b.x = xb_xcc_id(); b.st = st;
    if (threadIdx.x == 0) (void)xb_add(&bar[XB_XCNT(b.x)], 1u);
    return b;
}
__device__ __forceinline__ void xcd_barrier_complete(unsigned* bar, unsigned x, unsigned& nloc, unsigned& nx) {
    const unsigned G = gridDim.x * gridDim.y * gridDim.z;
    unsigned sum, cnt, mine, sp = 0u;
    for (;;) {
        sum = 0u; cnt = 0u; mine = 0u;
#pragma unroll
        for (unsigned j = 0; j < 16; ++j) { const unsigned c = xb_ld(&bar[XB_XCNT(j)]); sum += c; cnt += (c > 0u) ? 1u : 0u; mine = (j == x) ? c : mine; }
        if (sum == G) break;
        __builtin_amdgcn_s_sleep(1);
        if ((++sp & 255u) == 0u) { if (xb_ld(&bar[XB_TMO])) break; if (sp > XB_SPIN_CAP) { atomicAdd(&bar[XB_TMO], 1u); break; } }
    }
    nloc = mine > 0u ? mine : 1u; nx = cnt > 0u ? cnt : 1u;
}
__device__ __forceinline__ void xcd_barrier(const XcdBarrier& b) {
    asm volatile("s_waitcnt vmcnt(0)" ::: "memory");
    __syncthreads();
    if (threadIdx.x == 0) {
        unsigned* bar = b.bar;
        __builtin_amdgcn_s_waitcnt(0);
        unsigned nloc = b.st[0], nx = b.st[1];
        if (nloc == 0u) { xcd_barrier_complete(bar, b.x, nloc, nx); b.st[0] = nloc; b.st[1] = nx; }
        const unsigned old = xb_add(&bar[XB_XSUB(b.x)], 1u);
        const unsigned gen = old / nloc;
        if (old + 1u == (gen + 1u) * nloc) {
            __builtin_amdgcn_fence(__ATOMIC_RELEASE, "agent");
            asm volatile("s_waitcnt vmcnt(0)" ::: "memory");
            const unsigned og = xb_add(&bar[XB_TOP], 1u);
            const unsigned tg = og / nx;
            if (og + 1u == (tg + 1u) * nx) xb_add(&bar[XB_TOPGEN], 1u);
            else XB_SPIN(xb_ld(&bar[XB_TOPGEN]) == tg, bar);
            __builtin_amdgcn_fence(__ATOMIC_ACQUIRE, "agent");
            xb_add(&bar[XB_XGEN(b.x)], 1u);
            asm volatile("s_waitcnt vmcnt(0)" ::: "memory");
        } else {
            XB_SPIN(xb_ld(&bar[XB_XGEN(b.x)]) == gen, bar);
            __builtin_amdgcn_fence(__ATOMIC_ACQUIRE, "agent");
            asm volatile("s_waitcnt vmcnt(0)" ::: "memory");
        }
    }
    __syncthreads();
}

__device__ __forceinline__ void transpose_item(const float* W, int K, int N, bf16_t* WT, int k0, int ns0, int nd0, LAS float* scr, int lane) {
#pragma unroll 8
    for (int i = 0; i < 32; ++i) { const int kk = 2 * i + (lane >> 5); scr[kk * 33 + (lane & 31)] = W[(size_t)(k0 + kk) * N + ns0 + (lane & 31)]; }
    LDS_WAIT(); asm volatile("" ::: "memory");
    const int c = lane & 7;
#pragma unroll
    for (int j = 0; j < 4; ++j) { const int n = (lane >> 3) + 8 * j; const LAS float* s = scr + (8 * c) * 33 + n;
        u32x4 o; o.x = pk2(s[0 * 33], s[1 * 33]); o.y = pk2(s[2 * 33], s[3 * 33]); o.z = pk2(s[4 * 33], s[5 * 33]); o.w = pk2(s[6 * 33], s[7 * 33]);
        *(u32x4*)(WT + (size_t)(nd0 + n) * K + k0 + 8 * c) = o; }
    LDS_WAIT(); asm volatile("" ::: "memory");
}
__device__ __forceinline__ int map_in(int nd) {
    if (nd < 1024 || nd >= 2048) return nd;
    const int t = (nd - 1024) >> 8, i = (nd - 1024) & 255;
    return i < 128 ? 1024 + 128 * t + i : 1536 + 128 * t + (i - 128);
}

__device__ __forceinline__ void mod_item(LAS unsigned char* lds, int cg, const float* c, const float* w_ada, const float* b_ada, float* mod, int tid, int wave, int lane) {
    LAS float* cact = (LAS float*)lds;
    for (int i = tid; i < BATCH * D; i += 512) { const float v = c[i]; cact[i] = v * __builtin_amdgcn_rcpf(1.0f + __expf(-v)); }
    __syncthreads();
    float acc[32];
#pragma unroll
    for (int b = 0; b < 32; ++b) acc[b] = 0.f;
    const float* wp = w_ada + (size_t)(wave * 128) * (NMOD * D) + cg * 64 + lane;
    for (int k4 = 0; k4 < 32; ++k4) {
        const float w0 = wp[(size_t)(4 * k4 + 0) * (NMOD * D)], w1 = wp[(size_t)(4 * k4 + 1) * (NMOD * D)], w2 = wp[(size_t)(4 * k4 + 2) * (NMOD * D)], w3 = wp[(size_t)(4 * k4 + 3) * (NMOD * D)];
#pragma unroll
        for (int b = 0; b < 32; ++b) { const f32x4 cv = *(const LAS f32x4*)(cact + b * D + wave * 128 + 4 * k4); acc[b] += cv[0] * w0 + cv[1] * w1 + cv[2] * w2 + cv[3] * w3; }
    }
    __syncthreads();
    LAS float* part = (LAS float*)lds;
#pragma unroll
    for (int b = 0; b < 32; ++b) part[(wave * 32 + b) * 64 + lane] = acc[b];
    __syncthreads();
#pragma unroll
    for (int i = 0; i < 4; ++i) { const int o = tid + 512 * i, b = o >> 6, col = o & 63; float s = 0.f;
#pragma unroll
        for (int w = 0; w < 8; ++w) s += part[(w * 32 + b) * 64 + col];
        mod[b * (NMOD * D) + cg * 64 + col] = s + b_ada[cg * 64 + col]; }
    __syncthreads();
}

__device__ __forceinline__ void ssm_mats_item(LAS unsigned char* lds, int g, const float* lam_re, const float* lam_im, const float* log_dt, const float* b_re, const float* b_im,
                                              const float* c_re, const float* c_im, const float* d_skip, bf16_t* Bt1, bf16_t* Bt2, float* lam16, int tid) {
    LAS float* pwr = (LAS float*)lds; LAS float* pwi = pwr + 17 * 64;
    LAS float* bbr = pwi + 17 * 64;   LAS float* bbi = bbr + 1024;
    LAS float* ccr = bbi + 1024;      LAS float* cci = ccr + 1024;
    LAS float* km = cci + 1024;
    LAS float* dsk = km + 4096;
    const float dt = expf(log_dt[g]);
    for (int i = tid; i < 17 * 64; i += 512) { const int tau = i >> 6, p = i & 63; const float lr = lam_re[g * NP + p], li = lam_im[g * NP + p];
        const float e = expf((float)tau * lr * dt), ang = (float)tau * li * dt; pwr[i] = e * cosf(ang); pwi[i] = e * sinf(ang); }
    for (int i = tid; i < 1024; i += 512) { const int p = i >> 4, h = i & 15; const float lr = lam_re[g * NP + p], li = lam_im[g * NP + p];
        const float a = lr * dt, th = li * dt, em1 = expm1f(a), ct = cosf(th), st = sinf(th), sh = sinf(0.5f * th);
        const float nr = em1 * ct - 2.f * sh * sh, ni = (em1 + 1.f) * st;
        const float den = lr * lr + li * li, qr = (nr * lr + ni * li) / den, qi = (ni * lr - nr * li) / den;
        const float br = b_re[(g * NP + p) * NH + h], bi = b_im[(g * NP + p) * NH + h];
        bbr[i] = qr * br - qi * bi; bbi[i] = qr * bi + qi * br; }
    for (int i = tid; i < 1024; i += 512) { ccr[i] = c_re[g * 1024 + i]; cci[i] = c_im[g * 1024 + i]; }
    if (tid < 16) dsk[tid] = d_skip[g * NH + tid];
    __syncthreads();
    for (int i = tid; i < 4096; i += 512) { const int tau = i >> 8, h = (i >> 4) & 15, hp = i & 15; float s = 0.f;
        for (int p = 0; p < 64; ++p) { const float cr = ccr[h * 64 + p], ci = cci[h * 64 + p], pr = pwr[tau * 64 + p], pi = pwi[tau * 64 + p];
            const float xr = cr * pr - ci * pi, xi = cr * pi + ci * pr; s += xr * bbr[p * 16 + hp] - xi * bbi[p * 16 + hp]; }
        km[i] = s; }
    __syncthreads();
    bf16_t* B2g = Bt2 + (size_t)g * 256 * 512; bf16_t* B1g = Bt1 + (size_t)g * 128 * 256;
    for (int i = tid; i < 256 * 32; i += 512) { const int n = i >> 5, k8 = i & 31, j = n >> 4, h = n & 15, jp = k8 >> 1, hp0 = (k8 & 1) * 8; float v[8];
#pragma unroll
        for (int e = 0; e < 8; ++e) { float x = 0.f; if (j >= jp) { x = km[((j - jp) * 16 + h) * 16 + hp0 + e]; if (j == jp && h == hp0 + e) x += dsk[h]; } v[e] = x; }
        u32x4 o; o.x = pk2(v[0], v[1]); o.y = pk2(v[2], v[3]); o.z = pk2(v[4], v[5]); o.w = pk2(v[6], v[7]);
        *(u32x4*)(B2g + (size_t)n * 512 + k8 * 8) = o; }
    for (int i = tid; i < 256 * 64; i += 512) { const int n = i >> 6, p = i & 63, j = n >> 4, h = n & 15;
        const float cr = ccr[h * 64 + p], ci = cci[h * 64 + p], pr = pwr[(j + 1) * 64 + p], pi = pwi[(j + 1) * 64 + p];
        const float xr = cr * pr - ci * pi, xi = cr * pi + ci * pr; const unsigned a = f2bf(xr), b = f2bf(-xi);
        u32x2 o; o.x = a | (a << 16); o.y = b | (b << 16);
        *(u32x2*)(B2g + (size_t)n * 512 + 256 + 4 * p) = o; }
    for (int i = tid; i < 128 * 32; i += 512) { const int n = i >> 5, k8 = i & 31, p = n >> 1, im = n & 1, jp = k8 >> 1, hp0 = (k8 & 1) * 8; float v[8];
        const float pr = pwr[(15 - jp) * 64 + p], pi = pwi[(15 - jp) * 64 + p];
#pragma unroll
        for (int e = 0; e < 8; ++e) { const float br = bbr[p * 16 + hp0 + e], bi = bbi[p * 16 + hp0 + e]; v[e] = im ? (pr * bi + pi * br) : (pr * br - pi * bi); }
        u32x4 o; o.x = pk2(v[0], v[1]); o.y = pk2(v[2], v[3]); o.z = pk2(v[4], v[5]); o.w = pk2(v[6], v[7]);
        *(u32x4*)(B1g + (size_t)n * 256 + k8 * 8) = o; }
    if (tid < 64) { lam16[(g * 64 + tid) * 2] = pwr[16 * 64 + tid]; lam16[(g * 64 + tid) * 2 + 1] = pwi[16 * 64 + tid]; }
    __syncthreads();
}

__device__ __forceinline__ void norm_mod_rows(const float* src, const float* gvec, const float* shift, const float* scale, bf16_t* dst, int wave, int lane) {
    asm volatile("" : "+v"(lane));
    f32x4 gs[4], sh[4];
#pragma unroll
    for (int j = 0; j < 4; ++j) { const int col = 4 * lane + 256 * j; const f32x4 g = *(const f32x4*)(gvec + col), sc = *(const f32x4*)(scale + col); gs[j] = g * (sc + 1.0f); sh[j] = *(const f32x4*)(shift + col); }
    for (int r = wave; r < 256; r += NWAVES) {
        const f32x4* xr = (const f32x4*)(src + (size_t)r * D) + lane; f32x4 v[4]; float s = 0.f;
#pragma unroll
        for (int j = 0; j < 4; ++j) { v[j] = xr[64 * j]; s += (v[j][0] * v[j][0] + v[j][1] * v[j][1]) + (v[j][2] * v[j][2] + v[j][3] * v[j][3]); }
        const float rstd = rsqrtf(wave_sum(s) * (1.f / D) + RMS_EPS);
        unsigned long long* o8 = (unsigned long long*)(dst + (size_t)r * D) + lane;
#pragma unroll
        for (int j = 0; j < 4; ++j) { const f32x4 y = v[j] * rstd * gs[j] + sh[j]; o8[64 * j] = (unsigned long long)cvt_pk_bf16(y[0], y[1]) | ((unsigned long long)cvt_pk_bf16(y[2], y[3]) << 32); }
    }
}
__device__ __forceinline__ void final_norm_rows(float* io, const float* gvec, int wave, int lane) {
    asm volatile("" : "+v"(lane));
    f32x4 g[4];
#pragma unroll
    for (int j = 0; j < 4; ++j) g[j] = *(const f32x4*)(gvec + 4 * lane + 256 * j);
    for (int r = wave; r < 256; r += NWAVES) {
        f32x4* xr = (f32x4*)(io + (size_t)r * D) + lane; f32x4 v[4]; float s = 0.f;
#pragma unroll
        for (int j = 0; j < 4; ++j) { v[j] = xr[64 * j]; s += (v[j][0] * v[j][0] + v[j][1] * v[j][1]) + (v[j][2] * v[j][2] + v[j][3] * v[j][3]); }
        const float rstd = rsqrtf(wave_sum(s) * (1.f / D) + RMS_EPS);
#pragma unroll
        for (int j = 0; j < 4; ++j) xr[64 * j] = v[j] * rstd * g[j];
    }
}
__device__ __forceinline__ void conv_panel(const bf16_t* CB, const bf16_t* V, const float* conv_w, bf16_t* YC, int pm, int tid) {
    asm volatile("" : "+v"(tid));
    const int cp = tid & 63, rg = tid >> 6, c0 = cp * 8, r0 = rg * 32, t0 = (pm & 7) * 256 + r0;
    float w[3][8];
#pragma unroll
    for (int k = 0; k < 3; ++k)
#pragma unroll
        for (int e = 0; e < 8; ++e) w[k][e] = conv_w[k * DC + c0 + e];
    const bf16_t* vp = V + ((size_t)pm * 256 + r0) * DC + c0; const bf16_t* cbp = CB + ((size_t)pm * 256 + r0) * DC + c0;
    u32x4 vm2 = (u32x4){0u, 0u, 0u, 0u}, vm1 = (u32x4){0u, 0u, 0u, 0u};
    if (t0 >= 2) { vm2 = *(const u32x4*)(vp - 2 * DC); vm1 = *(const u32x4*)(vp - DC); }
    for (int r = 0; r < 32; ++r) {
        const u32x4 v0 = *(const u32x4*)(vp + (size_t)r * DC), cb = *(const u32x4*)(cbp + (size_t)r * DC);
        float y[8];
#pragma unroll
        for (int q = 0; q < 4; ++q) {
            y[2 * q]     = bf_lo(cb[q]) * (w[0][2 * q] * bf_lo(vm2[q]) + w[1][2 * q] * bf_lo(vm1[q]) + w[2][2 * q] * bf_lo(v0[q]));
            y[2 * q + 1] = bf_hi(cb[q]) * (w[0][2 * q + 1] * bf_hi(vm2[q]) + w[1][2 * q + 1] * bf_hi(vm1[q]) + w[2][2 * q + 1] * bf_hi(v0[q]));
        }
        u32x4 o; o.x = cvt_pk_bf16(y[0], y[1]); o.y = cvt_pk_bf16(y[2], y[3]); o.z = cvt_pk_bf16(y[4], y[5]); o.w = cvt_pk_bf16(y[6], y[7]);
        *(u32x4*)(YC + (size_t)(r0 + r) * DC + c0) = o;
        vm2 = vm1; vm1 = v0;
    }
}

__device__ __forceinline__ void ssm_phase(LAS unsigned char* lds, const bf16_t* U, const bf16_t* Bt1, const bf16_t* Bt2, const float* lam16, bf16_t* YG, int vcu, int G, int tid, int wave, int lane) {
    asm volatile("" : "+v"(tid), "+v"(lane));
    const int fr = lane & 15, fq = lane >> 4;
    for (int it0 = vcu * 4; it0 < NG * BATCH; it0 += 4 * G) {
        const int g = it0 >> 5;
        bf16x8 b1f[8], b2f[2][16];
        const bf16_t* B1g = Bt1 + (size_t)g * 128 * 256; const bf16_t* B2g = Bt2 + (size_t)g * 256 * 512;
#pragma unroll
        for (int kk = 0; kk < 8; ++kk) b1f[kk] = *(const bf16x8*)(B1g + (size_t)(16 * wave + fr) * 256 + 32 * kk + 8 * fq);
#pragma unroll
        for (int nt = 0; nt < 2; ++nt)
#pragma unroll
            for (int kk = 0; kk < 16; ++kk) b2f[nt][kk] = *(const bf16x8*)(B2g + (size_t)(16 * (2 * wave + nt) + fr) * 512 + 32 * kk + 8 * fq);
        const float l16r = lam16[(g * 64 + lane) * 2], l16i = lam16[(g * 64 + lane) * 2 + 1];
        if (tid < 128) ((LAS unsigned*)(lds + SSM_SOFF))[tid] = 0u;
#pragma unroll 1
        for (int i = 0; i < 4; ++i) {
            const int b = (it0 & 31) + i;
            const bf16_t* Ub = U + ((size_t)g * M + (size_t)b * SEQ) * 16;
#pragma unroll
            for (int q = 0; q < 8; ++q) { const int piece = tid + 512 * q, row = piece >> 5, slot = piece & 31; const u32x4 val = *(const u32x4*)(Ub + (size_t)piece * 8);
                *(LAS u32x4*)(lds + row * 512 + ((slot ^ (row & 15)) << 4)) = val; }
            __syncthreads();
#pragma unroll 1
            for (int r = 0; r < 8; ++r) { f32x4 acc = (f32x4){0.f, 0.f, 0.f, 0.f}; const int row = 16 * r + fr;
#pragma unroll
                for (int kk = 0; kk < 8; ++kk) { const bf16x8 af = *(const LAS bf16x8*)(lds + row * 512 + (((4 * kk + fq) ^ fr) << 4)); acc = __builtin_amdgcn_mfma_f32_16x16x32_bf16(b1f[kk], af, acc, 0, 0, 0); }
                const int rho = row + 1; *(LAS f32x4*)(lds + SSM_SOFF + rho * 512 + (((4 * wave + fq) ^ (rho & 15)) << 4)) = acc; }
            __syncthreads();
            if (wave == 0) { float sr = 0.f, si = 0.f;
#pragma unroll 8
                for (int c = 0; c < NCH; ++c) { const int rho = c + 1; LAS f32x2* ap = (LAS f32x2*)(lds + SSM_SOFF + rho * 512 + (((lane >> 1) ^ (rho & 15)) << 4) + (lane & 1) * 8);
                    const f32x2 v = *ap; const float nr = l16r * sr - l16i * si + v[0], ni = l16r * si + l16i * sr + v[1]; sr = nr; si = ni;
                    const unsigned rh = f2bf(sr), ih = f2bf(si); const unsigned rl = f2bf(sr - __uint_as_float(rh << 16)), il = f2bf(si - __uint_as_float(ih << 16));
                    u32x2 o; o.x = rh | (rl << 16); o.y = ih | (il << 16); *(LAS u32x2*)ap = o; } }
            __syncthreads();
#pragma unroll 1
            for (int r = 0; r < 8; ++r) { f32x4 a0 = (f32x4){0.f, 0.f, 0.f, 0.f}, a1 = a0; const int row = 16 * r + fr;
#pragma unroll
                for (int kk = 0; kk < 8; ++kk) { const bf16x8 af = *(const LAS bf16x8*)(lds + row * 512 + (((4 * kk + fq) ^ fr) << 4));
                    a0 = __builtin_amdgcn_mfma_f32_16x16x32_bf16(b2f[0][kk], af, a0, 0, 0, 0); a1 = __builtin_amdgcn_mfma_f32_16x16x32_bf16(b2f[1][kk], af, a1, 0, 0, 0); }
#pragma unroll
                for (int kk = 0; kk < 8; ++kk) { const bf16x8 af = *(const LAS bf16x8*)(lds + SSM_SOFF + row * 512 + (((4 * kk + fq) ^ (row & 15)) << 4));
                    a0 = __builtin_amdgcn_mfma_f32_16x16x32_bf16(b2f[0][8 + kk], af, a0, 0, 0, 0); a1 = __builtin_amdgcn_mfma_f32_16x16x32_bf16(b2f[1][8 + kk], af, a1, 0, 0, 0); }
                const size_t tok = (size_t)b * SEQ + 16 * row + 2 * wave;
                u32x2 o0, o1; o0.x = cvt_pk_bf16(gelu_tanh(a0[0]), gelu_tanh(a0[1])); o0.y = cvt_pk_bf16(gelu_tanh(a0[2]), gelu_tanh(a0[3]));
                o1.x = cvt_pk_bf16(gelu_tanh(a1[0]), gelu_tanh(a1[1])); o1.y = cvt_pk_bf16(gelu_tanh(a1[2]), gelu_tanh(a1[3]));
                *(u32x2*)(YG + tok * DS + g * 16 + 4 * fq) = o0; *(u32x2*)(YG + (tok + 1) * DS + g * 16 + 4 * fq) = o1; }
            __syncthreads();
        }
    }
}

struct Args { const float* in[24]; float* out; unsigned char* ws; int ph_lo, ph_hi, li, pad; };
__global__ void __launch_bounds__(NWAVES * 64, 2) mega_fwd(Args args) {
    extern __shared__ __attribute__((aligned(16))) unsigned char lds_raw[];
    LAS unsigned char* lds = (LAS unsigned char*)lds_raw;
    volatile LAS unsigned* MISC = (volatile LAS unsigned*)(lds + MISC_OFF);
    const int tid = threadIdx.x, lane = tid & 63, wave = __builtin_amdgcn_readfirstlane(tid >> 6);
    const int G = gridDim.x; const int bx = blockIdx.x; const int vcu = (G % 8 == 0) ? (bx % 8) * (G / 8) + bx / 8 : bx;
    unsigned char* ws = args.ws;
    unsigned* ctl = (unsigned*)(ws + WS_CTL);
    const float* x = args.in[0]; const float* cvec = args.in[1]; const float* norm1_g = args.in[2]; const float* norm2_g = args.in[3];
    const float* w_ada = args.in[4]; const float* b_ada = args.in[5]; const float* w_in = args.in[6];
    const float* lam_re = args.in[7]; const float* lam_im = args.in[8]; const float* log_dt = args.in[9];
    const float* b_re = args.in[10]; const float* b_im = args.in[11]; const float* c_re = args.in[12]; const float* c_im = args.in[13];
    const float* d_skip = args.in[14]; const float* w_glu = args.in[15]; const float* b_glu = args.in[16]; const float* conv_w = args.in[17];
    const float* w_proj_ssm = args.in[18]; const float* w_proj_conv = args.in[19]; const float* w_out = args.in[20];
    const float* w_ff1 = args.in[21]; const float* w_ff2 = args.in[22]; const float* final_g = args.in[23];
    float* out = args.out;
    float* mod = (float*)(ws + WS_MOD);
    bf16_t* WinT = (bf16_t*)(ws + WS_WIN); bf16_t* WgluT = (bf16_t*)(ws + WS_WGLU); bf16_t* PssmT = (bf16_t*)(ws + WS_PSSM); bf16_t* PconvT = (bf16_t*)(ws + WS_PCONV);
    bf16_t* WoutT = (bf16_t*)(ws + WS_WOUT); bf16_t* W1T = (bf16_t*)(ws + WS_W1); bf16_t* W2T = (bf16_t*)(ws + WS_W2);
    bf16_t* Bt1 = (bf16_t*)(ws + WS_BT1); bf16_t* Bt2 = (bf16_t*)(ws + WS_BT2); float* lam16 = (float*)(ws + WS_L16);
    bf16_t* HN = (bf16_t*)(ws + WS_HN); bf16_t* Ub = (bf16_t*)(ws + WS_U); bf16_t* CBb = (bf16_t*)(ws + WS_CB); bf16_t* Vb = (bf16_t*)(ws + WS_V); bf16_t* YGb = (bf16_t*)(ws + WS_YG);

    if (tid < 32) MISC[tid] = 0u;
    __syncthreads();
    XcdBarrier bar; bar.bar = ctl + CW_BAR + args.li * XCD_BAR_WORDS; bar.x = 0; bar.st = nullptr;
    if (MK_N_LAUNCHES == 1) bar = xcd_barrier_post(ctl + CW_BAR, MISC + 8);
    const int lo = args.ph_lo, hi = args.ph_hi;
#define IN(k) (lo <= (k) && (k) < hi)
#define BOTH(k) (IN(k) && IN((k) + 1))

    if ((PH_MASK & 1) && IN(0)) {
        for (int it = vcu; it < 128; it += G) {
            if (it < 96) mod_item(lds, it, cvec, w_ada, b_ada, mod, tid, wave, lane);
            else ssm_mats_item(lds, it - 96, lam_re, lam_im, log_dt, b_re, b_im, c_re, c_im, d_skip, Bt1, Bt2, lam16, tid);
        }
        {
            LAS float* scr = (LAS float*)(lds + wave * 16384);
            int gw, NGW; if (G > 128) { gw = (vcu - 128) * NWAVES + wave; NGW = (G - 128) * NWAVES; } else { gw = vcu * NWAVES + wave; NGW = G * NWAVES; }
            constexpr int I_IN = (D / 64) * (INC / 32), I_GLU = (DS / 64) * (DS / 32), I_PS = (DS / 64) * (D / 32), I_PC = I_PS, I_OUT = (D / 64) * (D / 32), I_1 = (D / 64) * (DFF / 32), I_2 = (DFF / 64) * (D / 32);
            constexpr int NITEMS = I_IN + I_GLU + I_PS + I_PC + I_OUT + I_1 + I_2;
            if (gw >= 0) for (int it = gw; it < NITEMS; it += NGW) {
                int r = it;
                if (r < I_IN) { const int nb = r % (INC / 32), kb = r / (INC / 32); transpose_item(w_in, D, INC, WinT, 64 * kb, map_in(32 * nb), 32 * nb, scr, lane); continue; } r -= I_IN;
                if (r < I_GLU) { const int nb = r % (DS / 32), kb = r / (DS / 32); transpose_item(w_glu, DS, DS, WgluT, 64 * kb, 32 * nb, 32 * nb, scr, lane); continue; } r -= I_GLU;
                if (r < I_PS) { const int nb = r % (D / 32), kb = r / (D / 32); transpose_item(w_proj_ssm, DS, D, PssmT, 64 * kb, 32 * nb, 32 * nb, scr, lane); continue; } r -= I_PS;
                if (r < I_PC) { const int nb = r % (D / 32), kb = r / (D / 32); transpose_item(w_proj_conv, DC, D, PconvT, 64 * kb, 32 * nb, 32 * nb, scr, lane); continue; } r -= I_PC;
                if (r < I_OUT) { const int nb = r % (D / 32), kb = r / (D / 32); transpose_item(w_out, D, D, WoutT, 64 * kb, 32 * nb, 32 * nb, scr, lane); continue; } r -= I_OUT;
                if (r < I_1) { const int nb = r % (DFF / 32), kb = r / (DFF / 32); transpose_item(w_ff1, D, DFF, W1T, 64 * kb, 32 * nb, 32 * nb, scr, lane); continue; } r -= I_1;
                { const int nb = r % (D / 32), kb = r / (D / 32); transpose_item(w_ff2, DFF, D, W2T, 64 * kb, 32 * nb, 32 * nb, scr, lane); }
            }
        }
        if (BOTH(0)) xcd_barrier(bar);
    }

    if ((PH_MASK & 2) && IN(1)) {
        for (int pm = vcu; pm < NPANEL; pm += G) {
            const int b = pm >> 3; const float* modb = mod + (size_t)b * (NMOD * D);
            bf16_t* HNp = HN + (size_t)pm * 256 * D; unsigned char* pl = ws + WS_PANEL + (size_t)pm * PANEL_BYTES;
            norm_mod_rows(x + (size_t)pm * 256 * D, norm1_g, modb + 0 * D, modb + 1 * D, HNp, wave, lane);
            VM_WAIT(); __syncthreads();
            SchedCols S{(const char*)HNp, (const char*)WinT, (size_t)256 * D * 2, INC / 256};
            EpiIn E{Ub, CBb, Vb, (bf16_t*)(pl + PL_GS), (bf16_t*)(pl + PL_GC), pm * 256};
            pg8::gemm_phase<EpiIn, SchedCols, true, true>(lds, D, S, E);
            VM_WAIT(); __syncthreads();
        }
        if (BOTH(1)) xcd_barrier(bar);
    }

    if ((PH_MASK & 4) && IN(2)) {
        for (int pm = vcu; pm < NPANEL; pm += G) {
            unsigned char* pl = ws + WS_PANEL + (size_t)pm * PANEL_BYTES;
            conv_panel(CBb, Vb, conv_w, (bf16_t*)(pl + PL_YC), pm, tid);
        }
        ssm_phase(lds, Ub, Bt1, Bt2, lam16, YGb, vcu, G, tid, wave, lane);
        if (BOTH(2)) xcd_barrier(bar);
    }

    if ((PH_MASK & 8) && IN(3)) {
        for (int pm = vcu; pm < NPANEL; pm += G) {
            const int b = pm >> 3; const float* modb = mod + (size_t)b * (NMOD * D);
            unsigned char* pl = ws + WS_PANEL + (size_t)pm * PANEL_BYTES;
            bf16_t* GSp = (bf16_t*)(pl + PL_GS); bf16_t* GCp = (bf16_t*)(pl + PL_GC); bf16_t* MGp = (bf16_t*)(pl + PL_MG); bf16_t* YSp = (bf16_t*)(pl + PL_YS); bf16_t* YCp = (bf16_t*)(pl + PL_YC);
            bf16_t* HIDp = (bf16_t*)pl; bf16_t* HNp = HN + (size_t)pm * 256 * D;
            const float* xp = x + (size_t)pm * 256 * D; float* op = out + (size_t)pm * 256 * D;
            VM_WAIT(); __syncthreads();
            if (PH_MASK & 16) {
                SchedCols S{(const char*)(YGb + (size_t)pm * 256 * DS), (const char*)WgluT, (size_t)256 * DS * 2, DS / 256};
                EpiGlu E{YGb, b_glu, YSp, pm * 256};
                pg8::gemm_phase<EpiGlu, SchedCols, true, true>(lds, DS, S, E);
            }
            VM_WAIT(); __syncthreads();
            if (PH_MASK & 32) {
                SchedMerge S{(const char*)YSp, (const char*)YCp, (const char*)PssmT, (const char*)PconvT, (size_t)256 * DS * 2};
                EpiMerge E{GSp, GCp, MGp};
                pg8::gemm_phase<EpiMerge, SchedMerge, true, true>(lds, DS, S, E);
            }
            VM_WAIT(); __syncthreads();
            if (PH_MASK & 64) {
                SchedCols S{(const char*)MGp, (const char*)WoutT, (size_t)256 * D * 2, D / 256};
                EpiRes E{xp, modb + 2 * D, op};
                pg8::gemm_phase<EpiRes, SchedCols, true, true>(lds, D, S, E);
            }
            VM_WAIT(); __syncthreads();
            if (PH_MASK & 512) norm_mod_rows(op, norm2_g, modb + 3 * D, modb + 4 * D, HNp, wave, lane);
            VM_WAIT(); __syncthreads();
            if (PH_MASK & 128) {
                SchedCols S{(const char*)HNp, (const char*)W1T, (size_t)256 * D * 2, DFF / 256};
                EpiRelu2 E{HIDp};
                pg8::gemm_phase<EpiRelu2, SchedCols, true, true>(lds, D, S, E);
            }
            VM_WAIT(); __syncthreads();
            if (PH_MASK & 256) {
                SchedCols S{(const char*)HIDp, (const char*)W2T, (size_t)256 * DFF * 2, D / 256};
                EpiRes E{op, modb + 5 * D, op};
                pg8::gemm_phase<EpiRes, SchedCols, true, true>(lds, DFF, S, E);
            }
            VM_WAIT(); __syncthreads();
            if (PH_MASK & 1024) final_norm_rows(op, final_g, wave, lane);
        }
    }
#undef IN
#undef BOTH
}

extern "C" void kernel_launch(void* const* d_in, const int* in_sizes, int n_in, void* d_out, int out_size, void* d_ws, size_t ws_size, hipStream_t stream) {
    static int grid = 0;
    if (grid == 0) {
        if (n_in != 24 || in_sizes[0] != M * D || out_size != M * D || ws_size < WS_END) { fprintf(stderr, "kernel_launch: unexpected shapes (n_in %d, in0 %d, out %d, ws %zu); nothing launched\n", n_in, n_in > 0 ? in_sizes[0] : -1, out_size, ws_size); grid = -1; return; }
        int dev = 0, cus = 0, per_cu = 0;
        if (hipGetDevice(&dev) != hipSuccess || hipDeviceGetAttribute(&cus, hipDeviceAttributeMultiprocessorCount, dev) != hipSuccess) { fprintf(stderr, "kernel_launch: device query failed\n"); grid = -1; return; }
        if (hipFuncSetAttribute((const void*)mega_fwd, hipFuncAttributeMaxDynamicSharedMemorySize, LDS_BYTES) != hipSuccess) { fprintf(stderr, "kernel_launch: hipFuncSetAttribute failed\n"); grid = -1; return; }
        if (hipOccupancyMaxActiveBlocksPerMultiprocessor(&per_cu, (const void*)mega_fwd, NWAVES * 64, LDS_BYTES) != hipSuccess || per_cu < 1) { fprintf(stderr, "kernel_launch: occupancy query reports %d workgroups per CU\n", per_cu); (void)hipGetLastError(); grid = -1; return; }
        grid = cus;
        if (grid > NPANEL) grid = NPANEL;
    }
    if (grid < 0) return;
    if (hipMemsetAsync((char*)d_ws + WS_CTL, 0, CTL_ZERO_BYTES, stream) != hipSuccess) { fprintf(stderr, "kernel_launch: memset failed\n"); return; }
    Args a{};
    for (int i = 0; i < 24; ++i) a.in[i] = (const float*)d_in[i];
    a.out = (float*)d_out; a.ws = (unsigned char*)d_ws;
    for (int li = 0; li < MK_N_LAUNCHES; ++li) {
        if (MK_N_LAUNCHES == 1) { a.ph_lo = 0; a.ph_hi = 4; } else { a.ph_lo = li; a.ph_hi = li + 1; }
        a.li = li;
        hipLaunchKernelGGL(mega_fwd, dim3(grid), dim3(NWAVES * 64), LDS_BYTES, stream, a);
        const hipError_t le = hipPeekAtLastError();
        if (le != hipSuccess) { fprintf(stderr, "kernel_launch: launch %d failed: %s\n", li, hipGetErrorName(le)); break; }
    }
}
```

```cpp
#include <hip/hip_runtime.h>
#include <cstdio>
#include <cstdint>

#define LAS __attribute__((address_space(3)))
#define GAS __attribute__((address_space(1)))
typedef unsigned short bf16_t;
typedef short bf16x8 __attribute__((ext_vector_type(8)));
typedef float f32x4 __attribute__((ext_vector_type(4)));
typedef float f32x2 __attribute__((ext_vector_type(2)));
typedef unsigned u32x4 __attribute__((ext_vector_type(4)));
typedef unsigned u32x2 __attribute__((ext_vector_type(2)));

#ifndef MK_N_LAUNCHES
#define MK_N_LAUNCHES 1
#endif
#ifndef XP_MODE
#define XP_MODE 4
#endif
#ifndef REP_MASK
#define REP_MASK 0
#endif

constexpr int D = 1024, BATCH = 32, SEQ = 2048, M = BATCH * SEQ, NPANEL = M / 256;
constexpr int DS = 512, DC = 512, DFF = 4096, INC = 4096, NMOD = 6;
constexpr int NG = 32, NH = 16, NP = 64, CT = 16, NCH = SEQ / CT;
constexpr float RMS_EPS = 1e-6f;

constexpr size_t MiB = 1u << 20;
constexpr size_t WS_CTL = 0, CTL_ZERO_BYTES = 1 * MiB;
constexpr size_t WS_MOD = 1 * MiB;
constexpr size_t WS_WIN = 2 * MiB;
constexpr size_t WS_WGLU = 10 * MiB;
constexpr size_t WS_PSSM = 11 * MiB;
constexpr size_t WS_PCONV = 12 * MiB;
constexpr size_t WS_WOUT = 13 * MiB;
constexpr size_t WS_W1 = 15 * MiB;
constexpr size_t WS_W2 = 23 * MiB;
constexpr size_t WS_BT1 = 31 * MiB;
constexpr size_t WS_BT2 = 33 * MiB;
constexpr size_t WS_L16 = 41 * MiB;
constexpr size_t WS_HN = 48 * MiB;
constexpr size_t WS_U = 176 * MiB;
constexpr size_t WS_CB = 240 * MiB;
constexpr size_t WS_V = 304 * MiB;
constexpr size_t WS_YG = 368 * MiB;
constexpr size_t WS_PANEL = 432 * MiB;
constexpr size_t PANEL_BYTES = 2 * MiB, PL_GS = 0, PL_GC = 512 * 1024, PL_MG = 1024 * 1024, PL_YS = 1536 * 1024, PL_YC = 1792 * 1024;
constexpr size_t WS_END = 944 * MiB;
constexpr int CW_TMO = 0, CW_BAR = 4096;

constexpr int RING_BYTES = 131072;
constexpr int MISC_OFF = 143360;
constexpr int LDS_BYTES = 147456;
constexpr int SSM_SOFF = 65536;
constexpr int NWAVES = 8;

#define RLX_AGENT __ATOMIC_RELAXED, __HIP_MEMORY_SCOPE_AGENT
#define LDS_WAIT() asm volatile("s_waitcnt lgkmcnt(0)" ::: "memory")
#define VM_WAIT() asm volatile("s_waitcnt vmcnt(0)" ::: "memory")

__device__ __forceinline__ unsigned f2bf(float f) { unsigned u = __builtin_bit_cast(unsigned, f); return (u + 0x7fffu + ((u >> 16) & 1u)) >> 16; }
__device__ __forceinline__ unsigned pk2(float lo, float hi) { return f2bf(lo) | (f2bf(hi) << 16); }
__device__ __forceinline__ unsigned cvt_pk_bf16(float lo, float hi) { unsigned r; asm volatile("v_cvt_pk_bf16_f32 %0, %1, %2" : "=v"(r) : "v"(lo), "v"(hi)); return r; }
__device__ __forceinline__ float bf_lo(unsigned w) { return __uint_as_float(w << 16); }
__device__ __forceinline__ float bf_hi(unsigned w) { return __uint_as_float(w & 0xffff0000u); }
__device__ __forceinline__ float fsigmoid(float v) { return __builtin_amdgcn_rcpf(1.0f + __expf(-v)); }
__device__ __forceinline__ float gelu_tanh(float v) { const float u = 0.7978845608028654f * (v + 0.044715f * v * v * v); return v * __builtin_amdgcn_rcpf(1.0f + __expf(-2.0f * u)); }
__device__ __forceinline__ float wave_sum(float v) {
#pragma unroll
    for (int o = 1; o < 64; o <<= 1) v += __shfl_xor(v, o);
    return v;
}

namespace pg8 {
constexpr int BM = 256, BK = 64, HALF = 128, HTB = HALF * BK * 2, STAGE_BYTES = 8 * HTB;
__device__ __forceinline__ int lds_byte(int r, int c) { const int st = (r >> 4) * 2 + (c >> 5), rr = r & 15, cc = c & 31, ob = rr * 64 + cc * 2; return st * 1024 + (ob ^ (((ob >> 9) & 1) << 5)); }
__device__ __forceinline__ void stage_rc(int b, int& R, int& C) { const int st = b / 1024, sb = b % 1024, swz = sb ^ (((sb >> 9) & 1) << 5); R = (st >> 1) * 16 + swz / 64; C = (st & 1) * 32 + (swz % 64) / 2; }
__device__ __forceinline__ int perm32(int rho) { const int n = rho >> 4, i = rho & 15; return 8 * (i >> 2) + 4 * n + (i & 3); }

struct UnitD { const char* A; const char* B; int pm; int pn; int part; int pad; };

template <class Epi, class Sched, bool ALIGN_EPI, bool SP2>
__device__ __forceinline__ void gemm_phase(LAS unsigned char* lds, const int K, const Sched& S, const Epi& E) {
    int tid_ = threadIdx.x; asm volatile("" : "+v"(tid_));
    const int tid = tid_, wid = __builtin_amdgcn_readfirstlane(tid >> 6), lane = tid & 63, wr = wid >> 2, wc = wid & 3, fr = lane & 15, fq = lane >> 4;
    const int nt = K / BK;
    unsigned voffA[2], voffB[2];
#pragma unroll
    for (int i = 0; i < 2; ++i) { int R, C; stage_rc(tid * 16 + i * 8192, R, C); const int Rb = Epi::PERM ? ((R & ~31) + perm32(R & 31)) : R;
        voffA[i] = (unsigned)(R * K + C) * 2u; voffB[i] = (unsigned)(Rb * K + C) * 2u; }
    const size_t kstep = (size_t)(BK * 2);
    const size_t hstep = (size_t)HALF * K * 2;
    const unsigned ldsw = (unsigned)wid * 1024u;
    const int aoff = lds_byte(wr * 64 + fr, fq * 8), boff = lds_byte(wc * 32 + fr, fq * 8);
#define PG8_SA(b, h) (((b) * 2 + (h)) * HTB)
#define PG8_SB(b, h) ((4 + (b) * 2 + (h)) * HTB)
#define PG8_STAGE(bufoff, gbase, voff) do { _Pragma("unroll") for (int _i = 0; _i < 2; ++_i) \
        __builtin_amdgcn_global_load_lds((const unsigned*)((const char*)(gbase) + (voff)[_i]), (LAS unsigned*)(lds + (bufoff) + ldsw + _i * 8192), 16, 0, 0); } while (0)
#define PG8_LDA(dst, b, h) do { _Pragma("unroll") for (int m = 0; m < 4; ++m) _Pragma("unroll") for (int k = 0; k < 2; ++k) dst[m][k] = *(const LAS bf16x8*)(lds + PG8_SA(b, h) + aoff + m * 2048 + k * 1024); } while (0)
#define PG8_LDB(dst, b, h) do { _Pragma("unroll") for (int n = 0; n < 2; ++n) _Pragma("unroll") for (int k = 0; k < 2; ++k) dst[n][k] = *(const LAS bf16x8*)(lds + PG8_SB(b, h) + boff + n * 2048 + k * 1024); } while (0)
#define PG8_MMA(ai, bj, At, Bt) do { __builtin_amdgcn_s_setprio(1); _Pragma("unroll") for (int m = 0; m < 4; ++m) _Pragma("unroll") for (int n = 0; n < 2; ++n) _Pragma("unroll") for (int k = 0; k < 2; ++k) \
        acc[ai][bj][m][n] = __builtin_amdgcn_mfma_f32_16x16x32_bf16(Bt[n][k], At[m][k], acc[ai][bj][m][n], 0, 0, 0); __builtin_amdgcn_s_setprio(0); } while (0)
#define PG8_WAIT_V(n) asm volatile("s_waitcnt vmcnt(" #n ")" ::: "memory")
#define PG8_WAIT_L(n) asm volatile("s_waitcnt lgkmcnt(" #n ")" ::: "memory")
#define PG8_BAR __builtin_amdgcn_s_barrier()
#define PG8_SCHED __builtin_amdgcn_sched_barrier(0)
    UnitD cur, nxt; int ui = 0;
    if (!S.next(0, cur)) return;
    f32x4 acc[2][2][4][2];
#pragma unroll
    for (int a = 0; a < 2; ++a)
#pragma unroll
        for (int b = 0; b < 2; ++b)
#pragma unroll
            for (int m = 0; m < 4; ++m)
#pragma unroll
                for (int n = 0; n < 2; ++n) acc[a][b][m][n] = (f32x4){0.f, 0.f, 0.f, 0.f};
    bf16x8 At[4][2], B0[2][2], B1[2][2];
    const char* cA = cur.A; const char* cB = cur.B;
    if constexpr (SP2) {
        PG8_STAGE(PG8_SB(0, 0), cB, voffB); PG8_STAGE(PG8_SB(0, 1), cB + hstep, voffB); PG8_STAGE(PG8_SA(0, 0), cA, voffA); PG8_STAGE(PG8_SA(0, 1), cA + hstep, voffA);
        if (wr == 1) PG8_BAR;
        PG8_WAIT_V(2); PG8_BAR;
        PG8_STAGE(PG8_SB(1, 0), cB + kstep, voffB); PG8_STAGE(PG8_SA(1, 0), cA + kstep, voffA); PG8_STAGE(PG8_SB(1, 1), cB + hstep + kstep, voffB);
        PG8_WAIT_V(6); PG8_BAR;
    } else {
        PG8_STAGE(PG8_SB(0, 0), cB, voffB); PG8_STAGE(PG8_SA(0, 0), cA, voffA); PG8_STAGE(PG8_SB(0, 1), cB + hstep, voffB); PG8_STAGE(PG8_SA(0, 1), cA + hstep, voffA);
        if (wr == 1) PG8_BAR;
        PG8_WAIT_V(4); PG8_BAR;
        PG8_STAGE(PG8_SB(1, 0), cB + kstep, voffB); PG8_STAGE(PG8_SA(1, 0), cA + kstep, voffA); PG8_STAGE(PG8_SB(1, 1), cB + hstep + kstep, voffB);
        PG8_WAIT_V(6); PG8_BAR;
    }
    for (;;) {
        const bool has_next = S.next(ui + 1, nxt);
        const char* nA = has_next ? nxt.A : cA; const char* nB = has_next ? nxt.B : cB;
        for (int t = 0; t < nt; t += 2) {
            const bool last = (t == nt - 2);
            const char* a1 = cA + (size_t)(t + 1) * kstep;
            const char* a2 = last ? nA : cA + (size_t)(t + 2) * kstep; const char* b2 = last ? nB : cB + (size_t)(t + 2) * kstep;
            const char* a3 = a2 + kstep; const char* b3 = b2 + kstep;
            if constexpr (SP2) {
            PG8_LDB(B0, 0, 0); PG8_LDB(B1, 0, 1); PG8_SCHED; PG8_LDA(At, 0, 0); PG8_STAGE(PG8_SA(1, 1), a1 + hstep, voffA);
            PG8_WAIT_V(8); PG8_WAIT_L(0); PG8_BAR; PG8_MMA(0, 0, At, B0); PG8_MMA(0, 1, At, B1); PG8_BAR; PG8_SCHED;
            PG8_LDA(At, 0, 1); PG8_STAGE(PG8_SB(0, 0), b2, voffB); PG8_STAGE(PG8_SB(0, 1), b2 + hstep, voffB); PG8_STAGE(PG8_SA(0, 0), a2, voffA);
            PG8_WAIT_V(8); PG8_WAIT_L(0); PG8_BAR; PG8_MMA(1, 0, At, B0); PG8_MMA(1, 1, At, B1); PG8_BAR; PG8_SCHED;
            PG8_LDB(B0, 1, 0); PG8_LDB(B1, 1, 1); PG8_SCHED; PG8_LDA(At, 1, 0); PG8_STAGE(PG8_SA(0, 1), a2 + hstep, voffA);
            PG8_WAIT_V(8); PG8_WAIT_L(0); PG8_BAR; PG8_MMA(0, 0, At, B0); PG8_MMA(0, 1, At, B1); PG8_BAR; PG8_SCHED;
            PG8_LDA(At, 1, 1); PG8_STAGE(PG8_SB(1, 0), b3, voffB); PG8_STAGE(PG8_SB(1, 1), b3 + hstep, voffB); PG8_STAGE(PG8_SA(1, 0), a3, voffA);
            PG8_WAIT_V(8); PG8_WAIT_L(0); PG8_BAR; PG8_MMA(1, 0, At, B0); PG8_MMA(1, 1, At, B1); PG8_BAR; PG8_SCHED;
            } else {
            PG8_LDB(B0, 0, 0); PG8_SCHED; PG8_LDA(At, 0, 0); PG8_STAGE(PG8_SA(1, 1), a1 + hstep, voffA);
            PG8_WAIT_L(8); PG8_BAR; PG8_WAIT_L(0); PG8_MMA(0, 0, At, B0); PG8_BAR; PG8_SCHED;
            PG8_LDB(B1, 0, 1); PG8_STAGE(PG8_SB(0, 0), b2, voffB);
            PG8_BAR; PG8_WAIT_L(0); PG8_MMA(0, 1, At, B1); PG8_BAR;
            PG8_LDA(At, 0, 1); PG8_STAGE(PG8_SA(0, 0), a2, voffA);
            PG8_BAR; PG8_WAIT_L(0); PG8_MMA(1, 0, At, B0); PG8_BAR; PG8_SCHED;
            PG8_STAGE(PG8_SB(0, 1), b2 + hstep, voffB);
            PG8_WAIT_V(6); PG8_BAR; PG8_MMA(1, 1, At, B1); PG8_BAR;
            PG8_LDB(B0, 1, 0); PG8_SCHED; PG8_LDA(At, 1, 0); PG8_STAGE(PG8_SA(0, 1), a2 + hstep, voffA);
            PG8_WAIT_L(8); PG8_BAR; PG8_WAIT_L(0); PG8_MMA(0, 0, At, B0); PG8_BAR; PG8_SCHED;
            PG8_LDB(B1, 1, 1); PG8_STAGE(PG8_SB(1, 0), b3, voffB);
            PG8_BAR; PG8_WAIT_L(0); PG8_MMA(0, 1, At, B1); PG8_BAR;
            PG8_LDA(At, 1, 1); PG8_STAGE(PG8_SA(1, 0), a3, voffA);
            PG8_BAR; PG8_WAIT_L(0); PG8_MMA(1, 0, At, B0); PG8_BAR; PG8_SCHED;
            PG8_STAGE(PG8_SB(1, 1), b3 + hstep, voffB);
            PG8_WAIT_V(6); PG8_BAR; PG8_MMA(1, 1, At, B1); PG8_BAR;
            }
        }
        if constexpr (ALIGN_EPI) { if (wr == 0) PG8_BAR; }
        const bool zero = E(acc, cur, wr, wc, fr, fq);
        if (!has_next) break;
        if (zero) {
#pragma unroll
        for (int a = 0; a < 2; ++a)
#pragma unroll
            for (int b = 0; b < 2; ++b)
#pragma unroll
                for (int m = 0; m < 4; ++m)
#pragma unroll
                    for (int n = 0; n < 2; ++n) acc[a][b][m][n] = (f32x4){0.f, 0.f, 0.f, 0.f};
        }
        cur = nxt; cA = nA; cB = nB; ++ui;
        if constexpr (ALIGN_EPI) { if (wr == 1) PG8_BAR; }
    }
    PG8_WAIT_V(0);
    if constexpr (!ALIGN_EPI) { if (wr == 0) PG8_BAR; }
    PG8_BAR;
#undef PG8_SA
#undef PG8_SB
#undef PG8_STAGE
#undef PG8_LDA
#undef PG8_LDB
#undef PG8_MMA
#undef PG8_WAIT_V
#undef PG8_WAIT_L
#undef PG8_BAR
#undef PG8_SCHED
}
}
using pg8::UnitD;

struct SchedGrp {
    const char* A0; const char* A1; const char* B0; const char* B1; size_t astep, bstep; int NT, nparts, vcu, G;
    __device__ __forceinline__ bool next(int i, UnitD& u) const {
        const int part = nparts == 2 ? (i & 1) : 0, j = nparts == 2 ? (i >> 1) : i;
        int pm, pn;
        if (G == 256) {
            const int x32 = vcu & ~31, l = vcu & 31;
            if (NT == 2) { if (j >= 2) return false; pm = x32 + 16 * j + (l >> 1); pn = l & 1; }
            else { const int ntg = NT >> 2; if (j >= NT) return false; pm = x32 + 8 * (j / ntg) + (l >> 2); pn = 4 * (j % ntg) + (l & 3); }
        } else { const long id = (long)j * G + vcu; if (id >= (long)NPANEL * NT) return false; pm = (int)(id / NT); pn = (int)(id % NT); }
        u.A = (part ? A1 : A0) + (size_t)pm * astep; u.B = (part ? B1 : B0) + (size_t)pn * bstep; u.pm = pm; u.pn = pn; u.part = part; u.pad = 0; return true;
    }
};

#define EPI_ROWS for (int ai = 0; ai < 2; ++ai) _Pragma("unroll") for (int m = 0; m < 4; ++m)
#define PANEL_PTR(pm, off) ((bf16_t*)(panels + (size_t)(pm) * PANEL_BYTES + (off)))
struct EpiIn { static constexpr bool PERM = true;
    bf16_t* U; bf16_t* CB; bf16_t* V; unsigned char* panels;
    __device__ __forceinline__ bool operator()(f32x4 (&acc)[2][2][4][2], const UnitD& u, int wr, int wc, int fr, int fq) const {
        asm volatile("" : "+v"(fr), "+v"(fq));
        const int pn = u.pn, cb8 = wc * 32 + 8 * fq, row0 = u.pm * 256;
        if (pn < 2) {
#pragma unroll
            EPI_ROWS { const int rowl = ai * 128 + wr * 64 + m * 16 + fr;
#pragma unroll
                for (int bj = 0; bj < 2; ++bj) { const int c = pn * 256 + bj * 128 + cb8; const f32x4 v0 = acc[ai][bj][m][0], v1 = acc[ai][bj][m][1];
                    u32x4 w; w.x = cvt_pk_bf16(v0[0], v0[1]); w.y = cvt_pk_bf16(v0[2], v0[3]); w.z = cvt_pk_bf16(v1[0], v1[1]); w.w = cvt_pk_bf16(v1[2], v1[3]);
                    *(u32x4*)(U + ((size_t)(c >> 4) * M + (size_t)(row0 + rowl)) * 16 + (c & 15)) = w; } }
        } else if (pn < 4) {
#pragma unroll
            EPI_ROWS { const int rowl = ai * 128 + wr * 64 + m * 16 + fr;
#pragma unroll
                for (int bj = 0; bj < 2; ++bj) { const int c = (pn - 2) * 256 + bj * 128 + cb8; const f32x4 v0 = acc[ai][bj][m][0], v1 = acc[ai][bj][m][1];
                    u32x4 w; w.x = cvt_pk_bf16(v0[0], v0[1]); w.y = cvt_pk_bf16(v0[2], v0[3]); w.z = cvt_pk_bf16(v1[0], v1[1]); w.w = cvt_pk_bf16(v1[2], v1[3]);
                    *(u32x4*)(CB + (size_t)(row0 + rowl) * DC + c) = w; } }
        } else if (pn < 8) {
#pragma unroll
            EPI_ROWS { const int rowl = ai * 128 + wr * 64 + m * 16 + fr; const int c = (pn - 4) * 128 + cb8;
                const f32x4 v0 = acc[ai][0][m][0] * acc[ai][1][m][0], v1 = acc[ai][0][m][1] * acc[ai][1][m][1];
                u32x4 w; w.x = cvt_pk_bf16(v0[0], v0[1]); w.y = cvt_pk_bf16(v0[2], v0[3]); w.z = cvt_pk_bf16(v1[0], v1[1]); w.w = cvt_pk_bf16(v1[2], v1[3]);
                *(u32x4*)(V + (size_t)(row0 + rowl) * DC + c) = w; }
        } else {
            bf16_t* dst = PANEL_PTR(u.pm, pn < 12 ? PL_GS : PL_GC); const float lo = pn < 12 ? 0.f : 1e-9f;
#pragma unroll
            EPI_ROWS { const int rowl = ai * 128 + wr * 64 + m * 16 + fr;
#pragma unroll
                for (int bj = 0; bj < 2; ++bj) { const int c = ((pn - 8) & 3) * 256 + bj * 128 + cb8; f32x4 v0 = acc[ai][bj][m][0], v1 = acc[ai][bj][m][1];
#pragma unroll
                    for (int j = 0; j < 4; ++j) { v0[j] = fmaxf(fsigmoid(v0[j]), lo); v1[j] = fmaxf(fsigmoid(v1[j]), lo); }
                    u32x4 w; w.x = cvt_pk_bf16(v0[0], v0[1]); w.y = cvt_pk_bf16(v0[2], v0[3]); w.z = cvt_pk_bf16(v1[0], v1[1]); w.w = cvt_pk_bf16(v1[2], v1[3]);
                    *(u32x4*)(dst + (size_t)rowl * D + c) = w; } }
        }
        return true;
    }
};
struct EpiGlu { static constexpr bool PERM = true;
    const bf16_t* YG; const float* bglu; unsigned char* panels;
    __device__ __forceinline__ bool operator()(f32x4 (&acc)[2][2][4][2], const UnitD& u, int wr, int wc, int fr, int fq) const {
        asm volatile("" : "+v"(fr), "+v"(fq));
        const int cb8 = wc * 32 + 8 * fq, row0 = u.pm * 256; bf16_t* YS = PANEL_PTR(u.pm, PL_YS);
#pragma unroll
        for (int bj = 0; bj < 2; ++bj) { const int c = u.pn * 256 + bj * 128 + cb8; const f32x4 b0 = *(const f32x4*)(bglu + c), b1 = *(const f32x4*)(bglu + c + 4);
#pragma unroll
            EPI_ROWS { const int rowl = ai * 128 + wr * 64 + m * 16 + fr;
                const u32x4 y = *(const u32x4*)(YG + (size_t)(row0 + rowl) * DS + c); const f32x4 z0 = acc[ai][bj][m][0] + b0, z1 = acc[ai][bj][m][1] + b1;
                u32x4 w; w.x = cvt_pk_bf16(bf_lo(y.x) * fsigmoid(z0[0]), bf_hi(y.x) * fsigmoid(z0[1])); w.y = cvt_pk_bf16(bf_lo(y.y) * fsigmoid(z0[2]), bf_hi(y.y) * fsigmoid(z0[3]));
                w.z = cvt_pk_bf16(bf_lo(y.z) * fsigmoid(z1[0]), bf_hi(y.z) * fsigmoid(z1[1])); w.w = cvt_pk_bf16(bf_lo(y.w) * fsigmoid(z1[2]), bf_hi(y.w) * fsigmoid(z1[3]));
                *(u32x4*)(YS + (size_t)rowl * DS + c) = w; } }
        return true;
    }
};
struct EpiMerge { static constexpr bool PERM = true;
    unsigned char* panels;
    __device__ __forceinline__ bool operator()(f32x4 (&acc)[2][2][4][2], const UnitD& u, int wr, int wc, int fr, int fq) const {
        asm volatile("" : "+v"(fr), "+v"(fq));
        const int cb8 = wc * 32 + 8 * fq; const bf16_t* GS = PANEL_PTR(u.pm, PL_GS); const bf16_t* GC = PANEL_PTR(u.pm, PL_GC); bf16_t* MG = PANEL_PTR(u.pm, PL_MG);
        if (u.part == 0) {
#pragma unroll
            EPI_ROWS { const int rowl = ai * 128 + wr * 64 + m * 16 + fr;
#pragma unroll
                for (int bj = 0; bj < 2; ++bj) { const int c = u.pn * 256 + bj * 128 + cb8;
                    const u32x4 a = *(const u32x4*)(GS + (size_t)rowl * D + c), b = *(const u32x4*)(GC + (size_t)rowl * D + c);
                    f32x4 r0, r1;
                    r0[0] = bf_lo(a.x) * __builtin_amdgcn_rcpf(bf_lo(b.x)); r0[1] = bf_hi(a.x) * __builtin_amdgcn_rcpf(bf_hi(b.x)); r0[2] = bf_lo(a.y) * __builtin_amdgcn_rcpf(bf_lo(b.y)); r0[3] = bf_hi(a.y) * __builtin_amdgcn_rcpf(bf_hi(b.y));
                    r1[0] = bf_lo(a.z) * __builtin_amdgcn_rcpf(bf_lo(b.z)); r1[1] = bf_hi(a.z) * __builtin_amdgcn_rcpf(bf_hi(b.z)); r1[2] = bf_lo(a.w) * __builtin_amdgcn_rcpf(bf_lo(b.w)); r1[3] = bf_hi(a.w) * __builtin_amdgcn_rcpf(bf_hi(b.w));
                    acc[ai][bj][m][0] *= r0; acc[ai][bj][m][1] *= r1; } }
            return false;
        }
#pragma unroll
        EPI_ROWS { const int rowl = ai * 128 + wr * 64 + m * 16 + fr;
#pragma unroll
            for (int bj = 0; bj < 2; ++bj) { const int c = u.pn * 256 + bj * 128 + cb8; const u32x4 b = *(const u32x4*)(GC + (size_t)rowl * D + c);
                const f32x4 v0 = acc[ai][bj][m][0], v1 = acc[ai][bj][m][1];
                u32x4 w; w.x = cvt_pk_bf16(v0[0] * bf_lo(b.x), v0[1] * bf_hi(b.x)); w.y = cvt_pk_bf16(v0[2] * bf_lo(b.y), v0[3] * bf_hi(b.y));
                w.z = cvt_pk_bf16(v1[0] * bf_lo(b.z), v1[1] * bf_hi(b.z)); w.w = cvt_pk_bf16(v1[2] * bf_lo(b.w), v1[3] * bf_hi(b.w));
                *(u32x4*)(MG + (size_t)rowl * D + c) = w; } }
        return true;
    }
};
struct EpiRes { static constexpr bool PERM = false;
    const float* base; const float* mod; float* out; int goff; int zero_gate;
    __device__ __forceinline__ bool operator()(f32x4 (&acc)[2][2][4][2], const UnitD& u, int wr, int wc, int fr, int fq) const {
        asm volatile("" : "+v"(fr), "+v"(fq));
        const int col0 = u.pn * 256 + wc * 32 + 4 * fq; const float* gate = mod + (size_t)(u.pm >> 3) * (NMOD * D) + goff;
        const float* bp = base + (size_t)u.pm * 256 * D; float* op = out + (size_t)u.pm * 256 * D;
        f32x4 gv[2][2];
#pragma unroll
        for (int bj = 0; bj < 2; ++bj)
#pragma unroll
            for (int n = 0; n < 2; ++n) { gv[bj][n] = *(const f32x4*)(gate + col0 + bj * 128 + n * 16); if (zero_gate) gv[bj][n] = (f32x4){0.f, 0.f, 0.f, 0.f}; }
#pragma unroll
        EPI_ROWS { const size_t off = (size_t)(ai * 128 + wr * 64 + m * 16 + fr) * D + col0;
#pragma unroll
            for (int bj = 0; bj < 2; ++bj)
#pragma unroll
                for (int n = 0; n < 2; ++n) { const f32x4 bs = *(const f32x4*)(bp + off + bj * 128 + n * 16); *(f32x4*)(op + off + bj * 128 + n * 16) = bs + gv[bj][n] * acc[ai][bj][m][n]; }
            asm volatile("" ::: "memory"); }
        return true;
    }
};
struct EpiRelu2 { static constexpr bool PERM = true;
    unsigned char* panels;
    __device__ __forceinline__ bool operator()(f32x4 (&acc)[2][2][4][2], const UnitD& u, int wr, int wc, int fr, int fq) const {
        asm volatile("" : "+v"(fr), "+v"(fq));
        const int cb8 = wc * 32 + 8 * fq; bf16_t* HID = PANEL_PTR(u.pm, 0);
#pragma unroll
        EPI_ROWS { const int rowl = ai * 128 + wr * 64 + m * 16 + fr;
#pragma unroll
            for (int bj = 0; bj < 2; ++bj) { const int c = u.pn * 256 + bj * 128 + cb8; f32x4 v0 = acc[ai][bj][m][0], v1 = acc[ai][bj][m][1];
#pragma unroll
                for (int j = 0; j < 4; ++j) { const float a = fmaxf(v0[j], 0.f), b = fmaxf(v1[j], 0.f); v0[j] = a * a; v1[j] = b * b; }
                u32x4 w; w.x = cvt_pk_bf16(v0[0], v0[1]); w.y = cvt_pk_bf16(v0[2], v0[3]); w.z = cvt_pk_bf16(v1[0], v1[1]); w.w = cvt_pk_bf16(v1[2], v1[3]);
                *(u32x4*)(HID + (size_t)rowl * DFF + c) = w; } }
        return true;
    }
};

#define XB_TMO      128
#define XB_XCNT(j)  (256  + 64 * (j))
#define XB_XSUB(j)  (1280 + 64 * (j))
#define XB_XGEN(j)  (2304 + 64 * (j))
#define XB_TOP      3328
#define XB_TOPGEN   3392
#define XCD_BAR_WORDS 3456
#define XB_SPIN_CAP (1u << 18)
__device__ __forceinline__ unsigned xb_ld(unsigned* p)              { return __hip_atomic_load(p, __ATOMIC_RELAXED, __HIP_MEMORY_SCOPE_AGENT); }
__device__ __forceinline__ unsigned xb_add(unsigned* p, unsigned v) { return __hip_atomic_fetch_add(p, v, __ATOMIC_RELAXED, __HIP_MEMORY_SCOPE_AGENT); }
__device__ __forceinline__ unsigned xb_xcc_id() { return (unsigned)__builtin_amdgcn_s_getreg((3 << 11) | 20) & 0xFu; }
#define XB_SPIN(cond, bar) do { unsigned _sp = 0; while (cond) { __builtin_amdgcn_s_sleep(1); \
    if ((++_sp & 255u) == 0u) { if (xb_ld(&(bar)[XB_TMO])) break; if (_sp > XB_SPIN_CAP) { atomicAdd(&(bar)[XB_TMO], 1u); break; } } } } while (0)
struct XcdBarrier { unsigned* bar; unsigned x; volatile LAS unsigned* st; };
__device__ __forceinline__ XcdBarrier xcd_barrier_post(unsigned* bar, volatile LAS unsigned* st) {
    XcdBarrier b; b.bar = bar; b.x = xb_xcc_id(); b.st = st;
    if (threadIdx.x == 0) (void)xb_add(&bar[XB_XCNT(b.x)], 1u);
    return b;
}
__device__ __forceinline__ void xcd_barrier_complete(unsigned* bar, unsigned x, unsigned& nloc, unsigned& nx) {
    const unsigned G = gridDim.x * gridDim.y * gridDim.z;
    unsigned sum, cnt, mine, sp = 0u;
    for (;;) {
        sum = 0u; cnt = 0u; mine = 0u;
#pragma unroll
        for (unsigned j = 0; j < 16; ++j) { const unsigned c = xb_ld(&bar[XB_XCNT(j)]); sum += c; cnt += (c > 0u) ? 1u : 0u; mine = (j == x) ? c : mine; }
        if (sum == G) break;
        __builtin_amdgcn_s_sleep(1);
        if ((++sp & 255u) == 0u) { if (xb_ld(&bar[XB_TMO])) break; if (sp > XB_SPIN_CAP) { atomicAdd(&bar[XB_TMO], 1u); break; } }
    }
    nloc = mine > 0u ? mine : 1u; nx = cnt > 0u ? cnt : 1u;
}
__device__ __forceinline__ void xcd_barrier(const XcdBarrier& b) {
    asm volatile("s_waitcnt vmcnt(0)" ::: "memory");
    __syncthreads();
    if (threadIdx.x == 0) {
        unsigned* bar = b.bar;
        __builtin_amdgcn_s_waitcnt(0);
        unsigned nloc = b.st[0], nx = b.st[1];
        if (nloc == 0u) { xcd_barrier_complete(bar, b.x, nloc, nx); b.st[0] = nloc; b.st[1] = nx; }
        const unsigned old = xb_add(&bar[XB_XSUB(b.x)], 1u);
        const unsigned gen = old / nloc;
        if (old + 1u == (gen + 1u) * nloc) {
            __builtin_amdgcn_fence(__ATOMIC_RELEASE, "agent");
            asm volatile("s_waitcnt vmcnt(0)" ::: "memory");
            const unsigned og = xb_add(&bar[XB_TOP], 1u);
            const unsigned tg = og / nx;
            if (og + 1u == (tg + 1u) * nx) xb_add(&bar[XB_TOPGEN], 1u);
            else XB_SPIN(xb_ld(&bar[XB_TOPGEN]) == tg, bar);
            __builtin_amdgcn_fence(__ATOMIC_ACQUIRE, "agent");
            xb_add(&bar[XB_XGEN(b.x)], 1u);
            asm volatile("s_waitcnt vmcnt(0)" ::: "memory");
        } else {
            XB_SPIN(xb_ld(&bar[XB_XGEN(b.x)]) == gen, bar);
            __builtin_amdgcn_fence(__ATOMIC_ACQUIRE, "agent");
            asm volatile("s_waitcnt vmcnt(0)" ::: "memory");
        }
    }
    __syncthreads();
}

__device__ __forceinline__ void transpose_item(const float* W, int K, int N, bf16_t* WT, int k0, int ns0, int nd0, LAS float* scr, int lane) {
#pragma unroll 8
    for (int i = 0; i < 32; ++i) { const int kk = 2 * i + (lane >> 5); scr[kk * 33 + (lane & 31)] = W[(size_t)(k0 + kk) * N + ns0 + (lane & 31)]; }
    LDS_WAIT(); asm volatile("" ::: "memory");
    const int c = lane & 7;
#pragma unroll
    for (int j = 0; j < 4; ++j) { const int n = (lane >> 3) + 8 * j; const LAS float* s = scr + (8 * c) * 33 + n;
        u32x4 o; o.x = pk2(s[0 * 33], s[1 * 33]); o.y = pk2(s[2 * 33], s[3 * 33]); o.z = pk2(s[4 * 33], s[5 * 33]); o.w = pk2(s[6 * 33], s[7 * 33]);
        *(u32x4*)(WT + (size_t)(nd0 + n) * K + k0 + 8 * c) = o; }
    LDS_WAIT(); asm volatile("" ::: "memory");
}
__device__ __forceinline__ int map_in(int nd) {
    if (nd < 1024 || nd >= 2048) return nd;
    const int t = (nd - 1024) >> 8, i = (nd - 1024) & 255;
    return i < 128 ? 1024 + 128 * t + i : 1536 + 128 * t + (i - 128);
}

__device__ __forceinline__ void mod_item(LAS unsigned char* lds, int cg, const float* c, const float* w_ada, const float* b_ada, float* mod, int tid, int wave, int lane) {
    LAS float* cact = (LAS float*)lds;
    for (int i = tid; i < BATCH * D; i += 512) { const float v = c[i]; cact[i] = v * __builtin_amdgcn_rcpf(1.0f + __expf(-v)); }
    __syncthreads();
    float acc[32];
#pragma unroll
    for (int b = 0; b < 32; ++b) acc[b] = 0.f;
    const float* wp = w_ada + (size_t)(wave * 128) * (NMOD * D) + cg * 64 + lane;
    for (int k4 = 0; k4 < 32; ++k4) {
        const float w0 = wp[(size_t)(4 * k4 + 0) * (NMOD * D)], w1 = wp[(size_t)(4 * k4 + 1) * (NMOD * D)], w2 = wp[(size_t)(4 * k4 + 2) * (NMOD * D)], w3 = wp[(size_t)(4 * k4 + 3) * (NMOD * D)];
#pragma unroll
        for (int b = 0; b < 32; ++b) { const f32x4 cv = *(const LAS f32x4*)(cact + b * D + wave * 128 + 4 * k4); acc[b] += cv[0] * w0 + cv[1] * w1 + cv[2] * w2 + cv[3] * w3; }
    }
    __syncthreads();
    LAS float* part = (LAS float*)lds;
#pragma unroll
    for (int b = 0; b < 32; ++b) part[(wave * 32 + b) * 64 + lane] = acc[b];
    __syncthreads();
#pragma unroll
    for (int i = 0; i < 4; ++i) { const int o = tid + 512 * i, b = o >> 6, col = o & 63; float s = 0.f;
#pragma unroll
        for (int w = 0; w < 8; ++w) s += part[(w * 32 + b) * 64 + col];
        mod[b * (NMOD * D) + cg * 64 + col] = s + b_ada[cg * 64 + col]; }
    __syncthreads();
}

__device__ __forceinline__ void ssm_mats_item(LAS unsigned char* lds, int g, const float* lam_re, const float* lam_im, const float* log_dt, const float* b_re, const float* b_im,
                                              const float* c_re, const float* c_im, const float* d_skip, bf16_t* Bt1, bf16_t* Bt2, float* lam16, int tid) {
    LAS float* pwr = (LAS float*)lds; LAS float* pwi = pwr + 17 * 64;
    LAS float* bbr = pwi + 17 * 64;   LAS float* bbi = bbr + 1024;
    LAS float* ccr = bbi + 1024;      LAS float* cci = ccr + 1024;
    LAS float* km = cci + 1024;
    LAS float* dsk = km + 4096;
    const float dt = expf(log_dt[g]);
    for (int i = tid; i < 17 * 64; i += 512) { const int tau = i >> 6, p = i & 63; const float lr = lam_re[g * NP + p], li = lam_im[g * NP + p];
        const float e = expf((float)tau * lr * dt), ang = (float)tau * li * dt; pwr[i] = e * cosf(ang); pwi[i] = e * sinf(ang); }
    for (int i = tid; i < 1024; i += 512) { const int p = i >> 4, h = i & 15; const float lr = lam_re[g * NP + p], li = lam_im[g * NP + p];
        const float a = lr * dt, th = li * dt, em1 = expm1f(a), ct = cosf(th), st = sinf(th), sh = sinf(0.5f * th);
        const float nr = em1 * ct - 2.f * sh * sh, ni = (em1 + 1.f) * st;
        const float den = lr * lr + li * li, qr = (nr * lr + ni * li) / den, qi = (ni * lr - nr * li) / den;
        const float br = b_re[(g * NP + p) * NH + h], bi = b_im[(g * NP + p) * NH + h];
        bbr[i] = qr * br - qi * bi; bbi[i] = qr * bi + qi * br; }
    for (int i = tid; i < 1024; i += 512) { ccr[i] = c_re[g * 1024 + i]; cci[i] = c_im[g * 1024 + i]; }
    if (tid < 16) dsk[tid] = d_skip[g * NH + tid];
    __syncthreads();
    for (int i = tid; i < 4096; i += 512) { const int tau = i >> 8, h = (i >> 4) & 15, hp = i & 15; float s = 0.f;
        for (int p = 0; p < 64; ++p) { const float cr = ccr[h * 64 + p], ci = cci[h * 64 + p], pr = pwr[tau * 64 + p], pi = pwi[tau * 64 + p];
            const float xr = cr * pr - ci * pi, xi = cr * pi + ci * pr; s += xr * bbr[p * 16 + hp] - xi * bbi[p * 16 + hp]; }
        km[i] = s; }
    __syncthreads();
    bf16_t* B2g = Bt2 + (size_t)g * 256 * 512; bf16_t* B1g = Bt1 + (size_t)g * 128 * 256;
    for (int i = tid; i < 256 * 32; i += 512) { const int n = i >> 5, k8 = i & 31, j = n >> 4, h = n & 15, jp = k8 >> 1, hp0 = (k8 & 1) * 8; float v[8];
#pragma unroll
        for (int e = 0; e < 8; ++e) { float x = 0.f; if (j >= jp) { x = km[((j - jp) * 16 + h) * 16 + hp0 + e]; if (j == jp && h == hp0 + e) x += dsk[h]; } v[e] = x; }
        u32x4 o; o.x = pk2(v[0], v[1]); o.y = pk2(v[2], v[3]); o.z = pk2(v[4], v[5]); o.w = pk2(v[6], v[7]);
        *(u32x4*)(B2g + (size_t)n * 512 + k8 * 8) = o; }
    for (int i = tid; i < 256 * 64; i += 512) { const int n = i >> 6, p = i & 63, j = n >> 4, h = n & 15;
        const float cr = ccr[h * 64 + p], ci = cci[h * 64 + p], pr = pwr[(j + 1) * 64 + p], pi = pwi[(j + 1) * 64 + p];
        const float xr = cr * pr - ci * pi, xi = cr * pi + ci * pr; const unsigned a = f2bf(xr), b = f2bf(-xi);
        u32x2 o; o.x = a | (a << 16); o.y = b | (b << 16);
        *(u32x2*)(B2g + (size_t)n * 512 + 256 + 4 * p) = o; }
    for (int i = tid; i < 128 * 32; i += 512) { const int n = i >> 5, k8 = i & 31, p = n >> 1, im = n & 1, jp = k8 >> 1, hp0 = (k8 & 1) * 8; float v[8];
        const float pr = pwr[(15 - jp) * 64 + p], pi = pwi[(15 - jp) * 64 + p];
#pragma unroll
        for (int e = 0; e < 8; ++e) { const float br = bbr[p * 16 + hp0 + e], bi = bbi[p * 16 + hp0 + e]; v[e] = im ? (pr * bi + pi * br) : (pr * br - pi * bi); }
        u32x4 o; o.x = pk2(v[0], v[1]); o.y = pk2(v[2], v[3]); o.z = pk2(v[4], v[5]); o.w = pk2(v[6], v[7]);
        *(u32x4*)(B1g + (size_t)n * 256 + k8 * 8) = o; }
    if (tid < 64) { lam16[(g * 64 + tid) * 2] = pwr[16 * 64 + tid]; lam16[(g * 64 + tid) * 2 + 1] = pwi[16 * 64 + tid]; }
    __syncthreads();
}

__device__ __forceinline__ void norm_mod_rows(const float* src, const float* gvec, const float* shift, const float* scale, bf16_t* dst, int wave, int lane) {
    asm volatile("" : "+v"(lane));
    f32x4 gs[4], sh[4];
#pragma unroll
    for (int j = 0; j < 4; ++j) { const int col = 4 * lane + 256 * j; const f32x4 g = *(const f32x4*)(gvec + col), sc = *(const f32x4*)(scale + col); gs[j] = g * (sc + 1.0f); sh[j] = *(const f32x4*)(shift + col); }
    for (int r = wave; r < 256; r += NWAVES) {
        const f32x4* xr = (const f32x4*)(src + (size_t)r * D) + lane; f32x4 v[4]; float s = 0.f;
#pragma unroll
        for (int j = 0; j < 4; ++j) { v[j] = xr[64 * j]; s += (v[j][0] * v[j][0] + v[j][1] * v[j][1]) + (v[j][2] * v[j][2] + v[j][3] * v[j][3]); }
        const float rstd = rsqrtf(wave_sum(s) * (1.f / D) + RMS_EPS);
        unsigned long long* o8 = (unsigned long long*)(dst + (size_t)r * D) + lane;
#pragma unroll
        for (int j = 0; j < 4; ++j) { const f32x4 y = v[j] * rstd * gs[j] + sh[j]; o8[64 * j] = (unsigned long long)cvt_pk_bf16(y[0], y[1]) | ((unsigned long long)cvt_pk_bf16(y[2], y[3]) << 32); }
    }
}
__device__ __forceinline__ void final_norm_rows(float* io, const float* gvec, int wave, int lane) {
    asm volatile("" : "+v"(lane));
    f32x4 g[4];
#pragma unroll
    for (int j = 0; j < 4; ++j) g[j] = *(const f32x4*)(gvec + 4 * lane + 256 * j);
    for (int r = wave; r < 256; r += NWAVES) {
        f32x4* xr = (f32x4*)(io + (size_t)r * D) + lane; f32x4 v[4]; float s = 0.f;
#pragma unroll
        for (int j = 0; j < 4; ++j) { v[j] = xr[64 * j]; s += (v[j][0] * v[j][0] + v[j][1] * v[j][1]) + (v[j][2] * v[j][2] + v[j][3] * v[j][3]); }
        const float rstd = rsqrtf(wave_sum(s) * (1.f / D) + RMS_EPS);
#pragma unroll
        for (int j = 0; j < 4; ++j) xr[64 * j] = v[j] * rstd * g[j];
    }
}
__device__ __forceinline__ void conv_panel(const bf16_t* CB, const bf16_t* V, const float* conv_w, bf16_t* YC, int pm, int tid) {
    asm volatile("" : "+v"(tid));
    const int cp = tid & 63, rg = tid >> 6, c0 = cp * 8, r0 = rg * 32, t0 = (pm & 7) * 256 + r0;
    float w[3][8];
#pragma unroll
    for (int k = 0; k < 3; ++k)
#pragma unroll
        for (int e = 0; e < 8; ++e) w[k][e] = conv_w[k * DC + c0 + e];
    const bf16_t* vp = V + ((size_t)pm * 256 + r0) * DC + c0; const bf16_t* cbp = CB + ((size_t)pm * 256 + r0) * DC + c0;
    u32x4 vm2 = (u32x4){0u, 0u, 0u, 0u}, vm1 = (u32x4){0u, 0u, 0u, 0u};
    if (t0 >= 2) { vm2 = *(const u32x4*)(vp - 2 * DC); vm1 = *(const u32x4*)(vp - DC); }
    for (int r = 0; r < 32; ++r) {
        const u32x4 v0 = *(const u32x4*)(vp + (size_t)r * DC), cb = *(const u32x4*)(cbp + (size_t)r * DC);
        float y[8];
#pragma unroll
        for (int q = 0; q < 4; ++q) {
            y[2 * q]     = bf_lo(cb[q]) * (w[0][2 * q] * bf_lo(vm2[q]) + w[1][2 * q] * bf_lo(vm1[q]) + w[2][2 * q] * bf_lo(v0[q]));
            y[2 * q + 1] = bf_hi(cb[q]) * (w[0][2 * q + 1] * bf_hi(vm2[q]) + w[1][2 * q + 1] * bf_hi(vm1[q]) + w[2][2 * q + 1] * bf_hi(v0[q]));
        }
        u32x4 o; o.x = cvt_pk_bf16(y[0], y[1]); o.y = cvt_pk_bf16(y[2], y[3]); o.z = cvt_pk_bf16(y[4], y[5]); o.w = cvt_pk_bf16(y[6], y[7]);
        *(u32x4*)(YC + (size_t)(r0 + r) * DC + c0) = o;
        vm2 = vm1; vm1 = v0;
    }
}

__device__ __forceinline__ void ssm_phase(LAS unsigned char* lds, const bf16_t* U, const bf16_t* Bt1, const bf16_t* Bt2, const float* lam16, bf16_t* YG, int vcu, int G, int tid, int wave, int lane) {
    asm volatile("" : "+v"(tid), "+v"(lane));
    const int fr = lane & 15, fq = lane >> 4;
    for (int it0 = vcu * 4; it0 < NG * BATCH; it0 += 4 * G) {
        const int g = it0 >> 5;
        bf16x8 b1f[8], b2f[2][16];
        const bf16_t* B1g = Bt1 + (size_t)g * 128 * 256; const bf16_t* B2g = Bt2 + (size_t)g * 256 * 512;
#pragma unroll
        for (int kk = 0; kk < 8; ++kk) b1f[kk] = *(const bf16x8*)(B1g + (size_t)(16 * wave + fr) * 256 + 32 * kk + 8 * fq);
#pragma unroll
        for (int nt = 0; nt < 2; ++nt)
#pragma unroll
            for (int kk = 0; kk < 16; ++kk) b2f[nt][kk] = *(const bf16x8*)(B2g + (size_t)(16 * (2 * wave + nt) + fr) * 512 + 32 * kk + 8 * fq);
        const float l16r = lam16[(g * 64 + lane) * 2], l16i = lam16[(g * 64 + lane) * 2 + 1];
        if (tid < 128) ((LAS unsigned*)(lds + SSM_SOFF))[tid] = 0u;
#pragma unroll 1
        for (int i = 0; i < 4; ++i) {
            const int b = (it0 & 31) + i;
            const bf16_t* Ub = U + ((size_t)g * M + (size_t)b * SEQ) * 16;
#pragma unroll
            for (int q = 0; q < 8; ++q) { const int piece = tid + 512 * q, row = piece >> 5, slot = piece & 31; const u32x4 val = *(const u32x4*)(Ub + (size_t)piece * 8);
                *(LAS u32x4*)(lds + row * 512 + ((slot ^ (row & 15)) << 4)) = val; }
            __syncthreads();
#pragma unroll 1
            for (int r = 0; r < 8; ++r) { f32x4 acc = (f32x4){0.f, 0.f, 0.f, 0.f}; const int row = 16 * r + fr;
#pragma unroll
                for (int kk = 0; kk < 8; ++kk) { const bf16x8 af = *(const LAS bf16x8*)(lds + row * 512 + (((4 * kk + fq) ^ fr) << 4)); acc = __builtin_amdgcn_mfma_f32_16x16x32_bf16(b1f[kk], af, acc, 0, 0, 0); }
                const int rho = row + 1; *(LAS f32x4*)(lds + SSM_SOFF + rho * 512 + (((4 * wave + fq) ^ (rho & 15)) << 4)) = acc; }
            __syncthreads();
            if (wave == 0) { float sr = 0.f, si = 0.f;
#pragma unroll 8
                for (int c = 0; c < NCH; ++c) { const int rho = c + 1; LAS f32x2* ap = (LAS f32x2*)(lds + SSM_SOFF + rho * 512 + (((lane >> 1) ^ (rho & 15)) << 4) + (lane & 1) * 8);
                    const f32x2 v = *ap; const float nr = l16r * sr - l16i * si + v[0], ni = l16r * si + l16i * sr + v[1]; sr = nr; si = ni;
                    const unsigned rh = f2bf(sr), ih = f2bf(si); const unsigned rl = f2bf(sr - __uint_as_float(rh << 16)), il = f2bf(si - __uint_as_float(ih << 16));
                    u32x2 o; o.x = rh | (rl << 16); o.y = ih | (il << 16); *(LAS u32x2*)ap = o; } }
            __syncthreads();
#pragma unroll 1
            for (int r = 0; r < 8; ++r) { f32x4 a0 = (f32x4){0.f, 0.f, 0.f, 0.f}, a1 = a0; const int row = 16 * r + fr;
#pragma unroll
                for (int kk = 0; kk < 8; ++kk) { const bf16x8 af = *(const LAS bf16x8*)(lds + row * 512 + (((4 * kk + fq) ^ fr) << 4));
                    a0 = __builtin_amdgcn_mfma_f32_16x16x32_bf16(b2f[0][kk], af, a0, 0, 0, 0); a1 = __builtin_amdgcn_mfma_f32_16x16x32_bf16(b2f[1][kk], af, a1, 0, 0, 0); }
#pragma unroll
                for (int kk = 0; kk < 8; ++kk) { const bf16x8 af = *(const LAS bf16x8*)(lds + SSM_SOFF + row * 512 + (((4 * kk + fq) ^ (row & 15)) << 4));
                    a0 = __builtin_amdgcn_mfma_f32_16x16x32_bf16(b2f[0][8 + kk], af, a0, 0, 0, 0); a1 = __builtin_amdgcn_mfma_f32_16x16x32_bf16(b2f[1][8 + kk], af, a1, 0, 0, 0); }
                const size_t tok = (size_t)b * SEQ + 16 * row + 2 * wave;
                u32x2 o0, o1; o0.x = cvt_pk_bf16(gelu_tanh(a0[0]), gelu_tanh(a0[1])); o0.y = cvt_pk_bf16(gelu_tanh(a0[2]), gelu_tanh(a0[3]));
                o1.x = cvt_pk_bf16(gelu_tanh(a1[0]), gelu_tanh(a1[1])); o1.y = cvt_pk_bf16(gelu_tanh(a1[2]), gelu_tanh(a1[3]));
                *(u32x2*)(YG + tok * DS + g * 16 + 4 * fq) = o0; *(u32x2*)(YG + (tok + 1) * DS + g * 16 + 4 * fq) = o1; }
            __syncthreads();
        }
    }
}

constexpr int NPHASE = 11;
struct Args { const float* in[24]; float* out; unsigned char* ws; int ph_lo, ph_hi, li, pad; };
__global__ void __launch_bounds__(NWAVES * 64, 2) mega_fwd(Args args) {
    extern __shared__ __attribute__((aligned(16))) unsigned char lds_raw[];
    LAS unsigned char* lds = (LAS unsigned char*)lds_raw;
    volatile LAS unsigned* MISC = (volatile LAS unsigned*)(lds + MISC_OFF);
    const int tid = threadIdx.x, lane = tid & 63, wave = __builtin_amdgcn_readfirstlane(tid >> 6);
    const int G = gridDim.x; const int bx = blockIdx.x; const int vcu = (G % 8 == 0) ? (bx % 8) * (G / 8) + bx / 8 : bx;
    unsigned char* ws = args.ws;
    unsigned* ctl = (unsigned*)(ws + WS_CTL);
    const float* x = args.in[0]; const float* cvec = args.in[1]; const float* norm1_g = args.in[2]; const float* norm2_g = args.in[3];
    const float* w_ada = args.in[4]; const float* b_ada = args.in[5]; const float* w_in = args.in[6];
    const float* lam_re = args.in[7]; const float* lam_im = args.in[8]; const float* log_dt = args.in[9];
    const float* b_re = args.in[10]; const float* b_im = args.in[11]; const float* c_re = args.in[12]; const float* c_im = args.in[13];
    const float* d_skip = args.in[14]; const float* w_glu = args.in[15]; const float* b_glu = args.in[16]; const float* conv_w = args.in[17];
    const float* w_proj_ssm = args.in[18]; const float* w_proj_conv = args.in[19]; const float* w_out = args.in[20];
    const float* w_ff1 = args.in[21]; const float* w_ff2 = args.in[22]; const float* final_g = args.in[23];
    float* out = args.out;
    float* mod = (float*)(ws + WS_MOD);
    bf16_t* WinT = (bf16_t*)(ws + WS_WIN); bf16_t* WgluT = (bf16_t*)(ws + WS_WGLU); bf16_t* PssmT = (bf16_t*)(ws + WS_PSSM); bf16_t* PconvT = (bf16_t*)(ws + WS_PCONV);
    bf16_t* WoutT = (bf16_t*)(ws + WS_WOUT); bf16_t* W1T = (bf16_t*)(ws + WS_W1); bf16_t* W2T = (bf16_t*)(ws + WS_W2);
    bf16_t* Bt1 = (bf16_t*)(ws + WS_BT1); bf16_t* Bt2 = (bf16_t*)(ws + WS_BT2); float* lam16 = (float*)(ws + WS_L16);
    bf16_t* HN = (bf16_t*)(ws + WS_HN); bf16_t* Ub = (bf16_t*)(ws + WS_U); bf16_t* CBb = (bf16_t*)(ws + WS_CB); bf16_t* Vb = (bf16_t*)(ws + WS_V); bf16_t* YGb = (bf16_t*)(ws + WS_YG);
    unsigned char* panels = ws + WS_PANEL;

    if (tid < 32) MISC[tid] = 0u;
    __syncthreads();
    XcdBarrier bar; bar.bar = ctl + CW_BAR; bar.x = 0; bar.st = nullptr;
    if (MK_N_LAUNCHES == 1) bar = xcd_barrier_post(ctl + CW_BAR, MISC + 8);
    const int lo = args.ph_lo, hi = args.ph_hi;
#define IN(k) (lo <= (k) && (k) < hi)
#define BOTH(k) (IN(k) && IN((k) + 1))
#define NREP(k) (((REP_MASK >> (k)) & 1) ? 2 : 1)
#define SEAM(k) do { if (BOTH(k)) xcd_barrier(bar); } while (0)

    if (IN(0)) {
#pragma unroll 1
      for (int rep = 0; rep < NREP(0); ++rep) {
        for (int it = vcu; it < 128; it += G) {
            if (it < 96) mod_item(lds, it, cvec, w_ada, b_ada, mod, tid, wave, lane);
            else ssm_mats_item(lds, it - 96, lam_re, lam_im, log_dt, b_re, b_im, c_re, c_im, d_skip, Bt1, Bt2, lam16, tid);
        }
        {
            LAS float* scr = (LAS float*)(lds + wave * 16384);
            int gw, NGW; if (G > 128) { gw = (vcu - 128) * NWAVES + wave; NGW = (G - 128) * NWAVES; } else { gw = vcu * NWAVES + wave; NGW = G * NWAVES; }
            constexpr int I_IN = (D / 64) * (INC / 32), I_GLU = (DS / 64) * (DS / 32), I_PS = (DS / 64) * (D / 32), I_PC = I_PS, I_OUT = (D / 64) * (D / 32), I_1 = (D / 64) * (DFF / 32), I_2 = (DFF / 64) * (D / 32);
            constexpr int NITEMS = I_IN + I_GLU + I_PS + I_PC + I_OUT + I_1 + I_2;
            if (gw >= 0) for (int it = gw; it < NITEMS; it += NGW) {
                int r = it;
                if (r < I_IN) { const int nb = r % (INC / 32), kb = r / (INC / 32); transpose_item(w_in, D, INC, WinT, 64 * kb, map_in(32 * nb), 32 * nb, scr, lane); continue; } r -= I_IN;
                if (r < I_GLU) { const int nb = r % (DS / 32), kb = r / (DS / 32); transpose_item(w_glu, DS, DS, WgluT, 64 * kb, 32 * nb, 32 * nb, scr, lane); continue; } r -= I_GLU;
                if (r < I_PS) { const int nb = r % (D / 32), kb = r / (D / 32); transpose_item(w_proj_ssm, DS, D, PssmT, 64 * kb, 32 * nb, 32 * nb, scr, lane); continue; } r -= I_PS;
                if (r < I_PC) { const int nb = r % (D / 32), kb = r / (D / 32); transpose_item(w_proj_conv, DC, D, PconvT, 64 * kb, 32 * nb, 32 * nb, scr, lane); continue; } r -= I_PC;
                if (r < I_OUT) { const int nb = r % (D / 32), kb = r / (D / 32); transpose_item(w_out, D, D, WoutT, 64 * kb, 32 * nb, 32 * nb, scr, lane); continue; } r -= I_OUT;
                if (r < I_1) { const int nb = r % (DFF / 32), kb = r / (DFF / 32); transpose_item(w_ff1, D, DFF, W1T, 64 * kb, 32 * nb, 32 * nb, scr, lane); continue; } r -= I_1;
                { const int nb = r % (D / 32), kb = r / (D / 32); transpose_item(w_ff2, DFF, D, W2T, 64 * kb, 32 * nb, 32 * nb, scr, lane); }
            }
        }
        __syncthreads();
      }
      SEAM(0);
    }
    if (IN(1)) {
#pragma unroll 1
      for (int rep = 0; rep < NREP(1); ++rep)
        for (int pm = vcu; pm < NPANEL; pm += G) { const float* modb = mod + (size_t)(pm >> 3) * (NMOD * D);
            norm_mod_rows(x + (size_t)pm * 256 * D, norm1_g, modb + 0 * D, modb + 1 * D, HN + (size_t)pm * 256 * D, wave, lane); }
      SEAM(1);
    }
    if (IN(2)) {
#pragma unroll 1
      for (int rep = 0; rep < NREP(2); ++rep) {
        SchedGrp S{(const char*)HN, (const char*)HN, (const char*)WinT, (const char*)WinT, (size_t)256 * D * 2, (size_t)256 * D * 2, INC / 256, 1, vcu, G};
        EpiIn E{Ub, CBb, Vb, panels};
        pg8::gemm_phase<EpiIn, SchedGrp, true, true>(lds, D, S, E);
      }
      SEAM(2);
    }
    if (IN(3)) {
#pragma unroll 1
      for (int rep = 0; rep < NREP(3); ++rep) {
        for (int pm = vcu; pm < NPANEL; pm += G) conv_panel(CBb, Vb, conv_w, PANEL_PTR(pm, PL_YC), pm, tid);
        ssm_phase(lds, Ub, Bt1, Bt2, lam16, YGb, vcu, G, tid, wave, lane);
      }
      SEAM(3);
    }
    if (IN(4)) {
#pragma unroll 1
      for (int rep = 0; rep < NREP(4); ++rep) {
        SchedGrp S{(const char*)YGb, (const char*)YGb, (const char*)WgluT, (const char*)WgluT, (size_t)256 * DS * 2, (size_t)256 * DS * 2, DS / 256, 1, vcu, G};
        EpiGlu E{YGb, b_glu, panels};
        pg8::gemm_phase<EpiGlu, SchedGrp, true, true>(lds, DS, S, E);
      }
      SEAM(4);
    }
    if (IN(5)) {
#pragma unroll 1
      for (int rep = 0; rep < NREP(5); ++rep) {
        SchedGrp S{(const char*)(panels + PL_YS), (const char*)(panels + PL_YC), (const char*)PssmT, (const char*)PconvT, PANEL_BYTES, (size_t)256 * DS * 2, D / 256, 2, vcu, G};
        EpiMerge E{panels};
        pg8::gemm_phase<EpiMerge, SchedGrp, true, true>(lds, DS, S, E);
      }
      SEAM(5);
    }
    if (IN(6)) {
#pragma unroll 1
      for (int rep = 0; rep < NREP(6); ++rep) {
        SchedGrp S{(const char*)(panels + PL_MG), (const char*)(panels + PL_MG), (const char*)WoutT, (const char*)WoutT, PANEL_BYTES, (size_t)256 * D * 2, D / 256, 1, vcu, G};
        EpiRes E{x, mod, out, 2 * D, 0};
        pg8::gemm_phase<EpiRes, SchedGrp, true, true>(lds, D, S, E);
      }
      SEAM(6);
    }
    if (IN(7)) {
#pragma unroll 1
      for (int rep = 0; rep < NREP(7); ++rep)
        for (int pm = vcu; pm < NPANEL; pm += G) { const float* modb = mod + (size_t)(pm >> 3) * (NMOD * D);
            norm_mod_rows(out + (size_t)pm * 256 * D, norm2_g, modb + 3 * D, modb + 4 * D, HN + (size_t)pm * 256 * D, wave, lane); }
      SEAM(7);
    }
    if (IN(8)) {
#pragma unroll 1
      for (int rep = 0; rep < NREP(8); ++rep) {
        SchedGrp S{(const char*)HN, (const char*)HN, (const char*)W1T, (const char*)W1T, (size_t)256 * D * 2, (size_t)256 * D * 2, DFF / 256, 1, vcu, G};
        EpiRelu2 E{panels};
        pg8::gemm_phase<EpiRelu2, SchedGrp, true, true>(lds, D, S, E);
      }
      SEAM(8);
    }
    if (IN(9)) {
#pragma unroll 1
      for (int rep = 0; rep < NREP(9); ++rep) {
        SchedGrp S{(const char*)panels, (const char*)panels, (const char*)W2T, (const char*)W2T, PANEL_BYTES, (size_t)256 * DFF * 2, D / 256, 1, vcu, G};
        EpiRes E{out, mod, out, 5 * D, (NREP(9) == 2 && rep == 0) ? 1 : 0};
        pg8::gemm_phase<EpiRes, SchedGrp, true, true>(lds, DFF, S, E);
      }
      SEAM(9);
    }
    if (IN(10)) {
        for (int pm = vcu; pm < NPANEL; pm += G) final_norm_rows(out + (size_t)pm * 256 * D, final_g, wave, lane);
    }
#undef IN
#undef BOTH
#undef NREP
#undef SEAM
}

extern "C" void kernel_launch(void* const* d_in, const int* in_sizes, int n_in, void* d_out, int out_size, void* d_ws, size_t ws_size, hipStream_t stream) {
    static int grid = 0;
    if (grid == 0) {
        if (n_in != 24 || in_sizes[0] != M * D || out_size != M * D || ws_size < WS_END) { fprintf(stderr, "kernel_launch: unexpected shapes (n_in %d, in0 %d, out %d, ws %zu); nothing launched\n", n_in, n_in > 0 ? in_sizes[0] : -1, out_size, ws_size); grid = -1; return; }
        int dev = 0, cus = 0, per_cu = 0;
        if (hipGetDevice(&dev) != hipSuccess || hipDeviceGetAttribute(&cus, hipDeviceAttributeMultiprocessorCount, dev) != hipSuccess) { fprintf(stderr, "kernel_launch: device query failed\n"); grid = -1; return; }
        if (hipFuncSetAttribute((const void*)mega_fwd, hipFuncAttributeMaxDynamicSharedMemorySize, LDS_BYTES) != hipSuccess) { fprintf(stderr, "kernel_launch: hipFuncSetAttribute failed\n"); grid = -1; return; }
        if (hipOccupancyMaxActiveBlocksPerMultiprocessor(&per_cu, (const void*)mega_fwd, NWAVES * 64, LDS_BYTES) != hipSuccess || per_cu < 1) { fprintf(stderr, "kernel_launch: occupancy query reports %d workgroups per CU\n", per_cu); (void)hipGetLastError(); grid = -1; return; }
        grid = cus;
        if (grid > NPANEL) grid = NPANEL;
    }
    if (grid < 0) return;
    if (hipMemsetAsync((char*)d_ws + WS_CTL, 0, CTL_ZERO_BYTES, stream) != hipSuccess) { fprintf(stderr, "kernel_launch: memset failed\n"); return; }
    Args a{};
    for (int i = 0; i < 24; ++i) a.in[i] = (const float*)d_in[i];
    a.out = (float*)d_out; a.ws = (unsigned char*)d_ws;
    for (int li = 0; li < MK_N_LAUNCHES; ++li) {
        if (MK_N_LAUNCHES == 1) { a.ph_lo = 0; a.ph_hi = NPHASE; } else { a.ph_lo = li; a.ph_hi = li + 1; }
        a.li = li;
        hipLaunchKernelGGL(mega_fwd, dim3(grid), dim3(NWAVES * 64), LDS_BYTES, stream, a);
        const hipError_t le = hipPeekAtLastError();
        if (le != hipSuccess) { fprintf(stderr, "kernel_launch: launch %d failed: %s\n", li, hipGetErrorName(le)); break; }
    }
}
```

```cpp
#include <hip/hip_runtime.h>
#include <cstdio>
#include <cstdint>

#define LAS __attribute__((address_space(3)))
#define GAS __attribute__((address_space(1)))
typedef unsigned short bf16_t;
typedef short bf16x8 __attribute__((ext_vector_type(8)));
typedef float f32x4 __attribute__((ext_vector_type(4)));
typedef float f32x16 __attribute__((ext_vector_type(16)));
typedef float f32x2 __attribute__((ext_vector_type(2)));
typedef unsigned u32x4 __attribute__((ext_vector_type(4)));
typedef unsigned u32x2 __attribute__((ext_vector_type(2)));

#ifndef MK_N_LAUNCHES
#define MK_N_LAUNCHES 1
#endif
#ifndef XP_MODE
#define XP_MODE 4
#endif
#ifndef GP16
#define GP16 8
#endif
#ifndef XP_GP
#define XP_GP 8
#endif
#ifndef KROT
#define KROT(v) 0
#endif
#ifndef XP_K
#define XP_K 0
#endif
#define XP_KROT(v) (XP_K == 1 ? 2 * ((v) >> 5) : XP_K == 2 ? 2 * ((v) & 7) : XP_K == 3 ? 2 * (((v) >> 2) & 7) : 0)
#ifndef XP_A
#define XP_A 0
#endif
#ifndef PG_ALIGN
#define PG_ALIGN true
#endif
#ifndef PG_SP2
#define PG_SP2 true
#endif
#ifndef EPI_REP
#define EPI_REP 0
#endif
#ifndef REP_MASK
#define REP_MASK 0
#endif

constexpr int D = 1024, BATCH = 32, SEQ = 2048, M = BATCH * SEQ, NPANEL = M / 256;
constexpr int DS = 512, DC = 512, DFF = 4096, INC = 4096, NMOD = 6;
constexpr int NG = 32, NH = 16, NP = 64, CT = 16, NCH = SEQ / CT;
constexpr float RMS_EPS = 1e-6f;

constexpr size_t MiB = 1u << 20;
constexpr size_t WS_CTL = 0, CTL_ZERO_BYTES = 1 * MiB;
constexpr size_t WS_MOD = 1 * MiB;
constexpr size_t WS_WIN = 2 * MiB;
constexpr size_t WS_WGLU = 10 * MiB;
constexpr size_t WS_PSSM = 11 * MiB;
constexpr size_t WS_PCONV = 12 * MiB;
constexpr size_t WS_WOUT = 13 * MiB;
constexpr size_t WS_W1 = 15 * MiB;
constexpr size_t WS_W2 = 23 * MiB;
constexpr size_t WS_BT1 = 31 * MiB;
constexpr size_t WS_BT2 = 33 * MiB;
constexpr size_t WS_L16 = 41 * MiB;
constexpr size_t WS_C2 = 42 * MiB;
constexpr size_t WS_GS2 = 42 * MiB + 512 * 1024;
constexpr size_t WS_ROWP = 43 * MiB;
constexpr size_t WS_HN = 48 * MiB;
constexpr size_t WS_U = 176 * MiB;
constexpr size_t WS_CB = 240 * MiB;
constexpr size_t WS_V = 304 * MiB;
constexpr size_t WS_YG = 368 * MiB;
constexpr size_t WS_PANEL = 432 * MiB;
constexpr size_t PANEL_BYTES = 2 * MiB, PL_GS = 0, PL_GC = 512 * 1024, PL_MG = 1024 * 1024, PL_YS = 1536 * 1024, PL_YC = 1792 * 1024;
constexpr size_t WS_END = 944 * MiB;
constexpr int CW_TMO = 0, CW_BAR = 4096;

constexpr int RING_BYTES = 131072;
constexpr int ROWSQ_OFF = 131072;
constexpr int MISC_OFF = 143360;
constexpr int LDS_BYTES = 147456;
constexpr int SSM_SOFF = 65536;
constexpr int NWAVES = 8;

#define RLX_AGENT __ATOMIC_RELAXED, __HIP_MEMORY_SCOPE_AGENT
#define LDS_WAIT() asm volatile("s_waitcnt lgkmcnt(0)" ::: "memory")
#define VM_WAIT() asm volatile("s_waitcnt vmcnt(0)" ::: "memory")

__device__ __forceinline__ unsigned f2bf(float f) { unsigned u = __builtin_bit_cast(unsigned, f); return (u + 0x7fffu + ((u >> 16) & 1u)) >> 16; }
__device__ __forceinline__ unsigned pk2(float lo, float hi) { return f2bf(lo) | (f2bf(hi) << 16); }
__device__ __forceinline__ unsigned cvt_pk_bf16(float lo, float hi) { unsigned r; asm volatile("v_cvt_pk_bf16_f32 %0, %1, %2" : "=v"(r) : "v"(lo), "v"(hi)); return r; }
__device__ __forceinline__ float bf_lo(unsigned w) { return __uint_as_float(w << 16); }
__device__ __forceinline__ float bf_hi(unsigned w) { return __uint_as_float(w & 0xffff0000u); }
__device__ __forceinline__ float fsigmoid(float v) { return __builtin_amdgcn_rcpf(1.0f + __expf(-v)); }
__device__ __forceinline__ float gelu_tanh(float v) { const float u = 0.7978845608028654f * (v + 0.044715f * v * v * v); return v * __builtin_amdgcn_rcpf(1.0f + __expf(-2.0f * u)); }
__device__ __forceinline__ float wave_sum(float v) {
#pragma unroll
    for (int o = 1; o < 64; o <<= 1) v += __shfl_xor(v, o);
    return v;
}

namespace pg8 {
constexpr int BM = 256, BK = 64, HALF = 128, HTB = HALF * BK * 2, STAGE_BYTES = 8 * HTB;
__device__ __forceinline__ int lds_byte(int r, int c) { const int st = (r >> 4) * 2 + (c >> 5), rr = r & 15, cc = c & 31, ob = rr * 64 + cc * 2; return st * 1024 + (ob ^ (((ob >> 9) & 1) << 5)); }
__device__ __forceinline__ void stage_rc(int b, int& R, int& C) { const int st = b / 1024, sb = b % 1024, swz = sb ^ (((sb >> 9) & 1) << 5); R = (st >> 1) * 16 + swz / 64; C = (st & 1) * 32 + (swz % 64) / 2; }
__device__ __forceinline__ int perm32(int rho) { const int n = rho >> 4, i = rho & 15; return 8 * (i >> 2) + 4 * n + (i & 3); }

struct UnitD { const char* A; const char* B; int pm; int pn; int part; int pad; };

template <class Epi, class Sched, bool ALIGN_EPI, bool SP2>
__device__ __forceinline__ void gemm_phase(LAS unsigned char* lds, const int K, const Sched& S, const Epi& E) {
    int tid_ = threadIdx.x; asm volatile("" : "+v"(tid_));
    const int tid = tid_, wid = __builtin_amdgcn_readfirstlane(tid >> 6), lane = tid & 63, wr = wid >> 2, wc = wid & 3, fr = lane & 15, fq = lane >> 4;
    const int nt = K / BK, krot = S.krot;
    unsigned voffA[2], voffB[2];
#pragma unroll
    for (int i = 0; i < 2; ++i) { int R, C; stage_rc(tid * 16 + i * 8192, R, C); const int Rb = Epi::PERM ? ((R & ~31) + perm32(R & 31)) : R;
        voffA[i] = (unsigned)(R * K + C) * 2u; voffB[i] = (unsigned)(Rb * K + C) * 2u; }
    const size_t kstep = (size_t)(BK * 2);
#define PG8_KOFF(t) ((size_t)(((t) + krot) & (nt - 1)) * kstep)
    const size_t hstep = (size_t)HALF * K * 2;
    const unsigned ldsw = (unsigned)wid * 1024u;
    const int aoff = lds_byte(wr * 64 + fr, fq * 8), boff = lds_byte(wc * 32 + fr, fq * 8);
#define PG8_SA(b, h) (((b) * 2 + (h)) * HTB)
#define PG8_SB(b, h) ((4 + (b) * 2 + (h)) * HTB)
#define PG8_STAGE(bufoff, gbase, voff) do { _Pragma("unroll") for (int _i = 0; _i < 2; ++_i) \
        __builtin_amdgcn_global_load_lds((const unsigned*)((const char*)(gbase) + (voff)[_i]), (LAS unsigned*)(lds + (bufoff) + ldsw + _i * 8192), 16, 0, 0); } while (0)
#define PG8_LDA(dst, b, h) do { _Pragma("unroll") for (int m = 0; m < 4; ++m) _Pragma("unroll") for (int k = 0; k < 2; ++k) dst[m][k] = *(const LAS bf16x8*)(lds + PG8_SA(b, h) + aoff + m * 2048 + k * 1024); } while (0)
#define PG8_LDB(dst, b, h) do { _Pragma("unroll") for (int n = 0; n < 2; ++n) _Pragma("unroll") for (int k = 0; k < 2; ++k) dst[n][k] = *(const LAS bf16x8*)(lds + PG8_SB(b, h) + boff + n * 2048 + k * 1024); } while (0)
#define PG8_MMA(ai, bj, At, Bt) do { __builtin_amdgcn_s_setprio(1); _Pragma("unroll") for (int m = 0; m < 4; ++m) _Pragma("unroll") for (int n = 0; n < 2; ++n) _Pragma("unroll") for (int k = 0; k < 2; ++k) \
        acc[ai][bj][m][n] = __builtin_amdgcn_mfma_f32_16x16x32_bf16(Bt[n][k], At[m][k], acc[ai][bj][m][n], 0, 0, 0); __builtin_amdgcn_s_setprio(0); } while (0)
#define PG8_WAIT_V(n) asm volatile("s_waitcnt vmcnt(" #n ")" ::: "memory")
#define PG8_WAIT_L(n) asm volatile("s_waitcnt lgkmcnt(" #n ")" ::: "memory")
#define PG8_BAR __builtin_amdgcn_s_barrier()
#define PG8_SCHED __builtin_amdgcn_sched_barrier(0)
    UnitD cur, nxt; int ui = 0;
    if (!S.next(0, cur)) return;
    f32x4 acc[2][2][4][2];
#pragma unroll
    for (int a = 0; a < 2; ++a)
#pragma unroll
        for (int b = 0; b < 2; ++b)
#pragma unroll
            for (int m = 0; m < 4; ++m)
#pragma unroll
                for (int n = 0; n < 2; ++n) acc[a][b][m][n] = (f32x4){0.f, 0.f, 0.f, 0.f};
    bf16x8 At[4][2], B0[2][2], B1[2][2];
    const char* cA = cur.A; const char* cB = cur.B;
    const size_t k0o = PG8_KOFF(0);
    if constexpr (SP2) {
        PG8_STAGE(PG8_SB(0, 0), cB + k0o, voffB); PG8_STAGE(PG8_SB(0, 1), cB + k0o + hstep, voffB); PG8_STAGE(PG8_SA(0, 0), cA + k0o, voffA); PG8_STAGE(PG8_SA(0, 1), cA + k0o + hstep, voffA);
        if (wr == 1) PG8_BAR;
        PG8_WAIT_V(2); PG8_BAR;
        PG8_STAGE(PG8_SB(1, 0), cB + k0o + kstep, voffB); PG8_STAGE(PG8_SA(1, 0), cA + k0o + kstep, voffA); PG8_STAGE(PG8_SB(1, 1), cB + k0o + hstep + kstep, voffB);
        PG8_WAIT_V(6); PG8_BAR;
    } else {
        PG8_STAGE(PG8_SB(0, 0), cB + k0o, voffB); PG8_STAGE(PG8_SA(0, 0), cA + k0o, voffA); PG8_STAGE(PG8_SB(0, 1), cB + k0o + hstep, voffB); PG8_STAGE(PG8_SA(0, 1), cA + k0o + hstep, voffA);
        if (wr == 1) PG8_BAR;
        PG8_WAIT_V(4); PG8_BAR;
        PG8_STAGE(PG8_SB(1, 0), cB + k0o + kstep, voffB); PG8_STAGE(PG8_SA(1, 0), cA + k0o + kstep, voffA); PG8_STAGE(PG8_SB(1, 1), cB + k0o + hstep + kstep, voffB);
        PG8_WAIT_V(6); PG8_BAR;
    }
    for (;;) {
        const bool has_next = S.next(ui + 1, nxt);
        const char* nA = has_next ? nxt.A : cA; const char* nB = has_next ? nxt.B : cB;
        for (int t = 0; t < nt; t += 2) {
            const bool last = (t == nt - 2);
            const char* a1 = cA + PG8_KOFF(t) + kstep;
            const size_t k2o = PG8_KOFF(t + 2);
            const char* a2 = (last ? nA : cA) + k2o; const char* b2 = (last ? nB : cB) + k2o;
            const char* a3 = a2 + kstep; const char* b3 = b2 + kstep;
            if constexpr (SP2) {
            PG8_LDB(B0, 0, 0); PG8_LDB(B1, 0, 1); PG8_SCHED; PG8_LDA(At, 0, 0); PG8_STAGE(PG8_SA(1, 1), a1 + hstep, voffA);
            PG8_WAIT_V(8); PG8_WAIT_L(0); PG8_BAR; PG8_MMA(0, 0, At, B0); PG8_MMA(0, 1, At, B1); PG8_BAR; PG8_SCHED;
            PG8_LDA(At, 0, 1); PG8_STAGE(PG8_SB(0, 0), b2, voffB); PG8_STAGE(PG8_SB(0, 1), b2 + hstep, voffB); PG8_STAGE(PG8_SA(0, 0), a2, voffA);
            PG8_WAIT_V(8); PG8_WAIT_L(0); PG8_BAR; PG8_MMA(1, 0, At, B0); PG8_MMA(1, 1, At, B1); PG8_BAR; PG8_SCHED;
            PG8_LDB(B0, 1, 0); PG8_LDB(B1, 1, 1); PG8_SCHED; PG8_LDA(At, 1, 0); PG8_STAGE(PG8_SA(0, 1), a2 + hstep, voffA);
            PG8_WAIT_V(8); PG8_WAIT_L(0); PG8_BAR; PG8_MMA(0, 0, At, B0); PG8_MMA(0, 1, At, B1); PG8_BAR; PG8_SCHED;
            PG8_LDA(At, 1, 1); PG8_STAGE(PG8_SB(1, 0), b3, voffB); PG8_STAGE(PG8_SB(1, 1), b3 + hstep, voffB); PG8_STAGE(PG8_SA(1, 0), a3, voffA);
            PG8_WAIT_V(8); PG8_WAIT_L(0); PG8_BAR; PG8_MMA(1, 0, At, B0); PG8_MMA(1, 1, At, B1); PG8_BAR; PG8_SCHED;
            } else {
            PG8_LDB(B0, 0, 0); PG8_SCHED; PG8_LDA(At, 0, 0); PG8_STAGE(PG8_SA(1, 1), a1 + hstep, voffA);
            PG8_WAIT_L(8); PG8_BAR; PG8_WAIT_L(0); PG8_MMA(0, 0, At, B0); PG8_BAR; PG8_SCHED;
            PG8_LDB(B1, 0, 1); PG8_STAGE(PG8_SB(0, 0), b2, voffB);
            PG8_BAR; PG8_WAIT_L(0); PG8_MMA(0, 1, At, B1); PG8_BAR;
            PG8_LDA(At, 0, 1); PG8_STAGE(PG8_SA(0, 0), a2, voffA);
            PG8_BAR; PG8_WAIT_L(0); PG8_MMA(1, 0, At, B0); PG8_BAR; PG8_SCHED;
            PG8_STAGE(PG8_SB(0, 1), b2 + hstep, voffB);
            PG8_WAIT_V(6); PG8_BAR; PG8_MMA(1, 1, At, B1); PG8_BAR;
            PG8_LDB(B0, 1, 0); PG8_SCHED; PG8_LDA(At, 1, 0); PG8_STAGE(PG8_SA(0, 1), a2 + hstep, voffA);
            PG8_WAIT_L(8); PG8_BAR; PG8_WAIT_L(0); PG8_MMA(0, 0, At, B0); PG8_BAR; PG8_SCHED;
            PG8_LDB(B1, 1, 1); PG8_STAGE(PG8_SB(1, 0), b3, voffB);
            PG8_BAR; PG8_WAIT_L(0); PG8_MMA(0, 1, At, B1); PG8_BAR;
            PG8_LDA(At, 1, 1); PG8_STAGE(PG8_SA(1, 0), a3, voffA);
            PG8_BAR; PG8_WAIT_L(0); PG8_MMA(1, 0, At, B0); PG8_BAR; PG8_SCHED;
            PG8_STAGE(PG8_SB(1, 1), b3 + hstep, voffB);
            PG8_WAIT_V(6); PG8_BAR; PG8_MMA(1, 1, At, B1); PG8_BAR;
            }
        }
        if constexpr (ALIGN_EPI) { if (wr == 0) PG8_BAR; }
        const bool zero = E(acc, cur, wr, wc, fr, fq);
        if constexpr (Epi::EPI_TWICE) { (void)E(acc, cur, wr, wc, fr, fq); }
        if (!has_next) break;
        if (zero) {
#pragma unroll
        for (int a = 0; a < 2; ++a)
#pragma unroll
            for (int b = 0; b < 2; ++b)
#pragma unroll
                for (int m = 0; m < 4; ++m)
#pragma unroll
                    for (int n = 0; n < 2; ++n) acc[a][b][m][n] = (f32x4){0.f, 0.f, 0.f, 0.f};
        }
        cur = nxt; cA = nA; cB = nB; ++ui;
        if constexpr (ALIGN_EPI) { if (wr == 1) PG8_BAR; }
    }
    PG8_WAIT_V(0);
    if constexpr (!ALIGN_EPI) { if (wr == 0) PG8_BAR; }
    PG8_BAR;
#undef PG8_KOFF
#undef PG8_SA
#undef PG8_SB
#undef PG8_STAGE
#undef PG8_LDA
#undef PG8_LDB
#undef PG8_MMA
#undef PG8_WAIT_V
#undef PG8_WAIT_L
#undef PG8_BAR
#undef PG8_SCHED
}
}
using pg8::UnitD;

struct SchedGrp {
    const char* A0; const char* A1; const char* B0; const char* B1; size_t astep, bstep; int NT, nparts, vcu, G, gp, krot, xpa;
    __device__ __forceinline__ bool next(int i, UnitD& u) const {
        const int part = nparts == 2 ? (i & 1) : 0, j = nparts == 2 ? (i >> 1) : i;
        int pm, pn;
        if (G == 256) {
            const int x32 = vcu & ~31, l = vcu & 31;
            if (NT == 2) { if (j >= 2) return false; pm = x32 + 16 * j + (l >> 1); pn = l & 1; }
            else { const int tp = 32 / gp, ntg = NT / tp; if (j >= NT) return false; pm = x32 + gp * (j / ntg) + (l / tp); pn = tp * (j % ntg) + (l % tp); if (xpa == 1) pm = x32 + (l / tp); if (xpa == 2) pm = x32 + gp * ((j / ntg) & 1) + (l / tp); }
        } else { const long id = (long)j * G + vcu; if (id >= (long)NPANEL * NT) return false; pm = (int)(id / NT); pn = (int)(id % NT); }
        u.A = (part ? A1 : A0) + (size_t)pm * astep; u.B = (part ? B1 : B0) + (size_t)pn * bstep; u.pm = pm; u.pn = pn; u.part = part; u.pad = 0; return true;
    }
};

#define EPI_SCHED __builtin_amdgcn_sched_barrier(0)
#define EPI_PIPE8(LD, PR, B0, B1) do { LD(0, B0); LD(1, B1); EPI_SCHED; PR(0, B0); EPI_SCHED; LD(2, B0); EPI_SCHED; PR(1, B1); EPI_SCHED; LD(3, B1); EPI_SCHED; PR(2, B0); EPI_SCHED; LD(4, B0); EPI_SCHED; \
    PR(3, B1); EPI_SCHED; LD(5, B1); EPI_SCHED; PR(4, B0); EPI_SCHED; LD(6, B0); EPI_SCHED; PR(5, B1); EPI_SCHED; LD(7, B1); EPI_SCHED; PR(6, B0); EPI_SCHED; PR(7, B1); EPI_SCHED; } while (0)
#define EPI_Q_AI(q) ((q) >> 2)
#define EPI_Q_BJ(q) (((q) >> 1) & 1)
#define EPI_Q_M(q, i) (2 * ((q) & 1) + (i))
#define EPI_ROWS for (int ai = 0; ai < 2; ++ai) _Pragma("unroll") for (int m = 0; m < 4; ++m)
#define PANEL_PTR(pm, off) ((bf16_t*)(panels + (size_t)(pm) * PANEL_BYTES + (off)))
struct EpiIn { static constexpr bool EPI_TWICE = (EPI_REP == 1); static constexpr bool PERM = true;
    bf16_t* U; bf16_t* CB; bf16_t* V; unsigned char* panels;
    __device__ __forceinline__ bool operator()(f32x4 (&acc)[2][2][4][2], const UnitD& u, int wr, int wc, int fr, int fq) const {
        asm volatile("" : "+v"(fr), "+v"(fq));
        const int pn = u.pn, cb8 = wc * 32 + 8 * fq, row0 = u.pm * 256;
        if (pn < 2) {
#pragma unroll
            EPI_ROWS { const int rowl = ai * 128 + wr * 64 + m * 16 + fr;
#pragma unroll
                for (int bj = 0; bj < 2; ++bj) { const int c = pn * 256 + bj * 128 + cb8; const f32x4 v0 = acc[ai][bj][m][0], v1 = acc[ai][bj][m][1];
                    u32x4 w; w.x = cvt_pk_bf16(v0[0], v0[1]); w.y = cvt_pk_bf16(v0[2], v0[3]); w.z = cvt_pk_bf16(v1[0], v1[1]); w.w = cvt_pk_bf16(v1[2], v1[3]);
                    *(u32x4*)(U + ((size_t)(c >> 4) * M + (size_t)(row0 + rowl)) * 16 + (c & 15)) = w; } }
        } else if (pn < 4) {
#pragma unroll
            EPI_ROWS { const int rowl = ai * 128 + wr * 64 + m * 16 + fr;
#pragma unroll
                for (int bj = 0; bj < 2; ++bj) { const int c = (pn - 2) * 256 + bj * 128 + cb8; const f32x4 v0 = acc[ai][bj][m][0], v1 = acc[ai][bj][m][1];
                    u32x4 w; w.x = cvt_pk_bf16(v0[0], v0[1]); w.y = cvt_pk_bf16(v0[2], v0[3]); w.z = cvt_pk_bf16(v1[0], v1[1]); w.w = cvt_pk_bf16(v1[2], v1[3]);
                    *(u32x4*)(CB + (size_t)(row0 + rowl) * DC + c) = w; } }
        } else if (pn < 8) {
#pragma unroll
            EPI_ROWS { const int rowl = ai * 128 + wr * 64 + m * 16 + fr; const int c = (pn - 4) * 128 + cb8;
                const f32x4 v0 = acc[ai][0][m][0] * acc[ai][1][m][0], v1 = acc[ai][0][m][1] * acc[ai][1][m][1];
                u32x4 w; w.x = cvt_pk_bf16(v0[0], v0[1]); w.y = cvt_pk_bf16(v0[2], v0[3]); w.z = cvt_pk_bf16(v1[0], v1[1]); w.w = cvt_pk_bf16(v1[2], v1[3]);
                *(u32x4*)(V + (size_t)(row0 + rowl) * DC + c) = w; }
        } else {
            bf16_t* dR = PANEL_PTR(u.pm, PL_GS); bf16_t* dC = PANEL_PTR(u.pm, PL_GC);
#pragma unroll
            EPI_ROWS { const int rowl = ai * 128 + wr * 64 + m * 16 + fr; const int c = (pn - 8) * 128 + cb8;
                f32x4 r0, r1, g0, g1;
#pragma unroll
                for (int j = 0; j < 4; ++j) { const float es0 = __expf(-acc[ai][0][m][0][j]), ec0 = fminf(__expf(-acc[ai][1][m][0][j]), 1e9f), es1 = __expf(-acc[ai][0][m][1][j]), ec1 = fminf(__expf(-acc[ai][1][m][1][j]), 1e9f);
                    g0[j] = __builtin_amdgcn_rcpf(1.0f + ec0); g1[j] = __builtin_amdgcn_rcpf(1.0f + ec1);
                    r0[j] = (1.0f + ec0) * __builtin_amdgcn_rcpf(1.0f + es0); r1[j] = (1.0f + ec1) * __builtin_amdgcn_rcpf(1.0f + es1); }
                u32x4 w; w.x = cvt_pk_bf16(r0[0], r0[1]); w.y = cvt_pk_bf16(r0[2], r0[3]); w.z = cvt_pk_bf16(r1[0], r1[1]); w.w = cvt_pk_bf16(r1[2], r1[3]);
                *(u32x4*)(dR + (size_t)rowl * D + c) = w;
                u32x4 v; v.x = cvt_pk_bf16(g0[0], g0[1]); v.y = cvt_pk_bf16(g0[2], g0[3]); v.z = cvt_pk_bf16(g1[0], g1[1]); v.w = cvt_pk_bf16(g1[2], g1[3]);
                *(u32x4*)(dC + (size_t)rowl * D + c) = v; }
        }
        return true;
    }
};
struct EpiGlu { static constexpr bool EPI_TWICE = false; static constexpr bool PERM = true;
    const bf16_t* YG; const float* bglu; unsigned char* panels;
    __device__ __forceinline__ bool operator()(f32x4 (&acc)[2][2][4][2], const UnitD& u, int wr, int wc, int fr, int fq) const {
        asm volatile("" : "+v"(fr), "+v"(fq));
        const int cb8 = wc * 32 + 8 * fq; bf16_t* YS = PANEL_PTR(u.pm, PL_YS); const bf16_t* yg = YG + (size_t)u.pm * 256 * DS;
        const unsigned rbase = (unsigned)(wr * 64 + fr) * DS + u.pn * 256 + cb8;
        f32x4 ba[2], bb[2];
#pragma unroll
        for (int bj = 0; bj < 2; ++bj) { const int c = u.pn * 256 + bj * 128 + cb8; ba[bj] = *(const f32x4*)(bglu + c); bb[bj] = *(const f32x4*)(bglu + c + 4); }
        u32x4 B0[2], B1[2];
#define EG_LD(q, B) do { _Pragma("unroll") for (int i = 0; i < 2; ++i) { const unsigned off = rbase + (unsigned)(EPI_Q_AI(q) * 128 + EPI_Q_M(q, i) * 16) * DS + EPI_Q_BJ(q) * 128; B[i] = *(const u32x4*)(yg + off); } } while (0)
#define EG_PR(q, B) do { constexpr int ai = EPI_Q_AI(q), bj = EPI_Q_BJ(q); _Pragma("unroll") for (int i = 0; i < 2; ++i) { constexpr int m0 = 2 * ((q) & 1); const int m = m0 + i; const unsigned off = rbase + (unsigned)(ai * 128 + m * 16) * DS + bj * 128; \
            const u32x4 y = B[i]; const f32x4 z0 = acc[ai][bj][m0 + i][0] + ba[bj], z1 = acc[ai][bj][m0 + i][1] + bb[bj]; \
            u32x4 w; w.x = cvt_pk_bf16(bf_lo(y.x) * fsigmoid(z0[0]), bf_hi(y.x) * fsigmoid(z0[1])); w.y = cvt_pk_bf16(bf_lo(y.y) * fsigmoid(z0[2]), bf_hi(y.y) * fsigmoid(z0[3])); \
            w.z = cvt_pk_bf16(bf_lo(y.z) * fsigmoid(z1[0]), bf_hi(y.z) * fsigmoid(z1[1])); w.w = cvt_pk_bf16(bf_lo(y.w) * fsigmoid(z1[2]), bf_hi(y.w) * fsigmoid(z1[3])); \
            *(u32x4*)(YS + off) = w; } } while (0)
        EPI_PIPE8(EG_LD, EG_PR, B0, B1);
#undef EG_LD
#undef EG_PR
        return true;
    }
};
struct EpiMerge { static constexpr bool EPI_TWICE = false; static constexpr bool PERM = true;
    unsigned char* panels;
    __device__ __forceinline__ bool operator()(f32x4 (&acc)[2][2][4][2], const UnitD& u, int wr, int wc, int fr, int fq) const {
        asm volatile("" : "+v"(fr), "+v"(fq));
        const int cb8 = wc * 32 + 8 * fq; const bf16_t* GT = PANEL_PTR(u.pm, u.part == 0 ? PL_GS : PL_GC); bf16_t* MG = PANEL_PTR(u.pm, PL_MG);
        const unsigned rbase = (unsigned)(wr * 64 + fr) * D + u.pn * 256 + cb8;
        u32x4 B0[2], B1[2];
#define EM_LD(q, B) do { _Pragma("unroll") for (int i = 0; i < 2; ++i) B[i] = *(const u32x4*)(GT + rbase + (unsigned)(EPI_Q_AI(q) * 128 + EPI_Q_M(q, i) * 16) * D + EPI_Q_BJ(q) * 128); } while (0)
#define EM_PR0(q, B) do { constexpr int ai = EPI_Q_AI(q), bj = EPI_Q_BJ(q), m0 = 2 * ((q) & 1); _Pragma("unroll") for (int i = 0; i < 2; ++i) { const u32x4 a = B[i]; \
            f32x4 r0, r1; r0[0] = bf_lo(a.x); r0[1] = bf_hi(a.x); r0[2] = bf_lo(a.y); r0[3] = bf_hi(a.y); r1[0] = bf_lo(a.z); r1[1] = bf_hi(a.z); r1[2] = bf_lo(a.w); r1[3] = bf_hi(a.w); \
            acc[ai][bj][m0 + i][0] *= r0; acc[ai][bj][m0 + i][1] *= r1; } } while (0)
#define EM_PR1(q, B) do { constexpr int ai = EPI_Q_AI(q), bj = EPI_Q_BJ(q), m0 = 2 * ((q) & 1); _Pragma("unroll") for (int i = 0; i < 2; ++i) { const u32x4 b = B[i]; const f32x4 v0 = acc[ai][bj][m0 + i][0], v1 = acc[ai][bj][m0 + i][1]; \
            u32x4 w; w.x = cvt_pk_bf16(v0[0] * bf_lo(b.x), v0[1] * bf_hi(b.x)); w.y = cvt_pk_bf16(v0[2] * bf_lo(b.y), v0[3] * bf_hi(b.y)); \
            w.z = cvt_pk_bf16(v1[0] * bf_lo(b.z), v1[1] * bf_hi(b.z)); w.w = cvt_pk_bf16(v1[2] * bf_lo(b.w), v1[3] * bf_hi(b.w)); \
            *(u32x4*)(MG + rbase + (unsigned)(ai * 128 + (m0 + i) * 16) * D + bj * 128) = w; } } while (0)
        if (u.part == 0) { EPI_PIPE8(EM_LD, EM_PR0, B0, B1); return false; }
        EPI_PIPE8(EM_LD, EM_PR1, B0, B1);
#undef EM_LD
#undef EM_PR0
#undef EM_PR1
        return true;
    }
};
struct EpiOut { static constexpr bool EPI_TWICE = false; static constexpr bool PERM = true;
    const float* x; const float* mod; const float* GS2; float* out; bf16_t* HN; float* ROWP; LAS float* rowsq;
    __device__ __forceinline__ bool operator()(f32x4 (&acc)[2][2][4][2], const UnitD& u, int wr, int wc, int fr, int fq) const {
        asm volatile("" : "+v"(fr), "+v"(fq));
        const int cb8 = wc * 32 + 8 * fq; const float* modb = mod + (size_t)(u.pm >> 3) * (NMOD * D); const float* gsb = GS2 + (size_t)(u.pm >> 3) * D;
        const float* xp = x + (size_t)u.pm * 256 * D; float* op = out + (size_t)u.pm * 256 * D; bf16_t* hp = HN + (size_t)u.pm * 256 * D;
        const unsigned rbase = (unsigned)(wr * 64 + fr) * D + u.pn * 256 + cb8;
        f32x4 ga[2], gb[2], na[2], nb[2];
#pragma unroll
        for (int bj = 0; bj < 2; ++bj) { const int c = u.pn * 256 + bj * 128 + cb8; ga[bj] = *(const f32x4*)(modb + 2 * D + c); gb[bj] = *(const f32x4*)(modb + 2 * D + c + 4); na[bj] = *(const f32x4*)(gsb + c); nb[bj] = *(const f32x4*)(gsb + c + 4); }
        float rs[2][4];
#pragma unroll
        for (int ai = 0; ai < 2; ++ai)
#pragma unroll
            for (int m = 0; m < 4; ++m) rs[ai][m] = 0.f;
        f32x4 B0[2][2], B1[2][2];
#define EO_LD(q, B) do { _Pragma("unroll") for (int i = 0; i < 2; ++i) { const unsigned off = rbase + (unsigned)(EPI_Q_AI(q) * 128 + EPI_Q_M(q, i) * 16) * D + EPI_Q_BJ(q) * 128; B[i][0] = *(const f32x4*)(xp + off); B[i][1] = *(const f32x4*)(xp + off + 4); } } while (0)
#define EO_PR(q, B) do { constexpr int ai = EPI_Q_AI(q), bj = EPI_Q_BJ(q), m0 = 2 * ((q) & 1); _Pragma("unroll") for (int i = 0; i < 2; ++i) { const unsigned off = rbase + (unsigned)(ai * 128 + (m0 + i) * 16) * D + bj * 128; \
            const f32x4 y0 = B[i][0] + ga[bj] * acc[ai][bj][m0 + i][0], y1 = B[i][1] + gb[bj] * acc[ai][bj][m0 + i][1]; \
            *(f32x4*)(op + off) = y0; *(f32x4*)(op + off + 4) = y1; \
            rs[ai][m0 + i] += (y0[0] * y0[0] + y0[1] * y0[1]) + (y0[2] * y0[2] + y0[3] * y0[3]) + (y1[0] * y1[0] + y1[1] * y1[1]) + (y1[2] * y1[2] + y1[3] * y1[3]); \
            const f32x4 h0 = y0 * na[bj], h1 = y1 * nb[bj]; \
            u32x4 w; w.x = cvt_pk_bf16(h0[0], h0[1]); w.y = cvt_pk_bf16(h0[2], h0[3]); w.z = cvt_pk_bf16(h1[0], h1[1]); w.w = cvt_pk_bf16(h1[2], h1[3]); \
            *(u32x4*)(hp + off) = w; } } while (0)
        EPI_PIPE8(EO_LD, EO_PR, B0, B1);
#undef EO_LD
#undef EO_PR
#pragma unroll
        for (int ai = 0; ai < 2; ++ai)
#pragma unroll
            for (int m = 0; m < 4; ++m) { float v = rs[ai][m]; v += __shfl_xor(v, 16); v += __shfl_xor(v, 32); if (fq == 0) rowsq[wc * 256 + ai * 128 + wr * 64 + m * 16 + fr] = v; }
        asm volatile("s_waitcnt lgkmcnt(0)" ::: "memory"); __builtin_amdgcn_s_barrier(); asm volatile("" ::: "memory");
        { const int t = threadIdx.x; if (t < 256) ROWP[((size_t)u.pm * 256 + t) * 4 + u.pn] = (rowsq[t] + rowsq[256 + t]) + (rowsq[512 + t] + rowsq[768 + t]); }
        asm volatile("s_waitcnt lgkmcnt(0)" ::: "memory"); __builtin_amdgcn_s_barrier(); asm volatile("" ::: "memory");
        return true;
    }
};
struct EpiRes { static constexpr bool EPI_TWICE = false; static constexpr bool PERM = true;
    const float* base; const float* mod; float* out; int goff; int zero_gate;
    __device__ __forceinline__ bool operator()(f32x4 (&acc)[2][2][4][2], const UnitD& u, int wr, int wc, int fr, int fq) const {
        asm volatile("" : "+v"(fr), "+v"(fq));
        const int cb8 = wc * 32 + 8 * fq; const float* gate = mod + (size_t)(u.pm >> 3) * (NMOD * D) + goff;
        const float* bp = base + (size_t)u.pm * 256 * D; float* op = out + (size_t)u.pm * 256 * D;
        const unsigned rbase = (unsigned)(wr * 64 + fr) * D + u.pn * 256 + cb8;
        f32x4 ga[2], gb[2];
#pragma unroll
        for (int bj = 0; bj < 2; ++bj) { const int c = u.pn * 256 + bj * 128 + cb8; ga[bj] = *(const f32x4*)(gate + c); gb[bj] = *(const f32x4*)(gate + c + 4); if (zero_gate) { ga[bj] = (f32x4){0.f, 0.f, 0.f, 0.f}; gb[bj] = ga[bj]; } }
        f32x4 B0[2][2], B1[2][2];
#define ER_LD(q, B) do { _Pragma("unroll") for (int i = 0; i < 2; ++i) { const unsigned off = rbase + (unsigned)(EPI_Q_AI(q) * 128 + EPI_Q_M(q, i) * 16) * D + EPI_Q_BJ(q) * 128; B[i][0] = *(const f32x4*)(bp + off); B[i][1] = *(const f32x4*)(bp + off + 4); } } while (0)
#define ER_PR(q, B) do { constexpr int ai = EPI_Q_AI(q), bj = EPI_Q_BJ(q), m0 = 2 * ((q) & 1); _Pragma("unroll") for (int i = 0; i < 2; ++i) { const unsigned off = rbase + (unsigned)(ai * 128 + (m0 + i) * 16) * D + bj * 128; \
            *(f32x4*)(op + off) = B[i][0] + ga[bj] * acc[ai][bj][m0 + i][0]; *(f32x4*)(op + off + 4) = B[i][1] + gb[bj] * acc[ai][bj][m0 + i][1]; } } while (0)
        EPI_PIPE8(ER_LD, ER_PR, B0, B1);
#undef ER_LD
#undef ER_PR
        return true;
    }
};
struct EpiRelu2 { static constexpr bool EPI_TWICE = (EPI_REP == 2 || EPI_REP == 3); static constexpr bool PERM = true;
    unsigned char* panels; unsigned char* dummy; const float* C2; const float* ROWP; mutable int pass;
    __device__ __forceinline__ bool operator()(f32x4 (&acc)[2][2][4][2], const UnitD& u, int wr, int wc, int fr, int fq) const {
        asm volatile("" : "+v"(fr), "+v"(fq));
        const int cb8 = wc * 32 + 8 * fq; bf16_t* HID = PANEL_PTR(u.pm, 0);
        const float* c2b = C2 + (size_t)(u.pm >> 3) * DFF; const float* rp = ROWP + (size_t)u.pm * 256 * 4;
        if (EPI_REP == 3 && ((pass++) & 1)) {
            unsigned char* dp = dummy + (size_t)(blockIdx.x * 8 + wr * 4 + wc) * 16384 + (fq * 16 + fr) * 16;
#pragma unroll
            EPI_ROWS {
#pragma unroll
                for (int bj = 0; bj < 2; ++bj) { f32x4 v0 = acc[ai][bj][m][0], v1 = acc[ai][bj][m][1];
#pragma unroll
                    for (int j = 0; j < 4; ++j) { const float a = fmaxf(v0[j], 0.f), b = fmaxf(v1[j], 0.f); v0[j] = a * a; v1[j] = b * b; }
                    u32x4 w; w.x = cvt_pk_bf16(v0[0], v0[1]); w.y = cvt_pk_bf16(v0[2], v0[3]); w.z = cvt_pk_bf16(v1[0], v1[1]); w.w = cvt_pk_bf16(v1[2], v1[3]);
                    *(u32x4*)(dp + ((ai * 4 + m) * 2 + bj) * 1024) = w; } }
            return true;
        }
        f32x4 ca[2], cb[2];
#pragma unroll
        for (int bj = 0; bj < 2; ++bj) { const int c = u.pn * 256 + bj * 128 + cb8; ca[bj] = *(const f32x4*)(c2b + c); cb[bj] = *(const f32x4*)(c2b + c + 4); }
#pragma unroll
        EPI_ROWS { const int rowl = ai * 128 + wr * 64 + m * 16 + fr;
            const f32x4 p = *(const f32x4*)(rp + (size_t)rowl * 4); const float rstd = rsqrtf(((p[0] + p[1]) + (p[2] + p[3])) * (1.f / D) + RMS_EPS);
#pragma unroll
            for (int bj = 0; bj < 2; ++bj) { const int c = u.pn * 256 + bj * 128 + cb8; f32x4 v0 = acc[ai][bj][m][0] * rstd + ca[bj], v1 = acc[ai][bj][m][1] * rstd + cb[bj];
#pragma unroll
                for (int j = 0; j < 4; ++j) { const float a = fmaxf(v0[j], 0.f), b = fmaxf(v1[j], 0.f); v0[j] = a * a; v1[j] = b * b; }
                u32x4 w; w.x = cvt_pk_bf16(v0[0], v0[1]); w.y = cvt_pk_bf16(v0[2], v0[3]); w.z = cvt_pk_bf16(v1[0], v1[1]); w.w = cvt_pk_bf16(v1[2], v1[3]);
                *(u32x4*)(HID + (size_t)rowl * DFF + c) = w; } }
        return true;
    }
};

#define XB_TMO      128
#define XB_XCNT(j)  (256  + 64 * (j))
#define XB_XSUB(j)  (1280 + 64 * (j))
#define XB_XGEN(j)  (2304 + 64 * (j))
#define XB_TOP      3328
#define XB_TOPGEN   3392
#define XCD_BAR_WORDS 3456
#define XB_SPIN_CAP (1u << 18)
__device__ __forceinline__ unsigned xb_ld(unsigned* p)              { return __hip_atomic_load(p, __ATOMIC_RELAXED, __HIP_MEMORY_SCOPE_AGENT); }
__device__ __forceinline__ unsigned xb_add(unsigned* p, unsigned v) { return __hip_atomic_fetch_add(p, v, __ATOMIC_RELAXED, __HIP_MEMORY_SCOPE_AGENT); }
__device__ __forceinline__ unsigned xb_xcc_id() { return (unsigned)__builtin_amdgcn_s_getreg((3 << 11) | 20) & 0xFu; }
#define XB_SPIN(cond, bar) do { unsigned _sp = 0; while (cond) { __builtin_amdgcn_s_sleep(1); \
    if ((++_sp & 255u) == 0u) { if (xb_ld(&(bar)[XB_TMO])) break; if (_sp > XB_SPIN_CAP) { atomicAdd(&(bar)[XB_TMO], 1u); break; } } } } while (0)
struct XcdBarrier { unsigned* bar; unsigned x; volatile LAS unsigned* st; };
__device__ __forceinline__ XcdBarrier xcd_barrier_post(unsigned* bar, volatile LAS unsigned* st) {
    XcdBarrier b; b.bar = bar; b.x = xb_xcc_id(); b.st = st;
    if (threadIdx.x == 0) (void)xb_add(&bar[XB_XCNT(b.x)], 1u);
    return b;
}
__device__ __forceinline__ void xcd_barrier_complete(unsigned* bar, unsigned x, unsigned& nloc, unsigned& nx) {
    const unsigned G = gridDim.x * gridDim.y * gridDim.z;
    unsigned sum, cnt, mine, sp = 0u;
    for (;;) {
        sum = 0u; cnt = 0u; mine = 0u;
#pragma unroll
        for (unsigned j = 0; j < 16; ++j) { const unsigned c = xb_ld(&bar[XB_XCNT(j)]); sum += c; cnt += (c > 0u) ? 1u : 0u; mine = (j == x) ? c : mine; }
        if (sum == G) break;
        __builtin_amdgcn_s_sleep(1);
        if ((++sp & 255u) == 0u) { if (xb_ld(&bar[XB_TMO])) break; if (sp > XB_SPIN_CAP) { atomicAdd(&bar[XB_TMO], 1u); break; } }
    }
    nloc = mine > 0u ? mine : 1u; nx = cnt > 0u ? cnt : 1u;
}
__device__ __forceinline__ void xcd_barrier(const XcdBarrier& b) {
    asm volatile("s_waitcnt vmcnt(0)" ::: "memory");
    __syncthreads();
    if (threadIdx.x == 0) {
        unsigned* bar = b.bar;
        __builtin_amdgcn_s_waitcnt(0);
        unsigned nloc = b.st[0], nx = b.st[1];
        if (nloc == 0u) { xcd_barrier_complete(bar, b.x, nloc, nx); b.st[0] = nloc; b.st[1] = nx; }
        const unsigned old = xb_add(&bar[XB_XSUB(b.x)], 1u);
        const unsigned gen = old / nloc;
        if (old + 1u == (gen + 1u) * nloc) {
            __builtin_amdgcn_fence(__ATOMIC_RELEASE, "agent");
            asm volatile("s_waitcnt vmcnt(0)" ::: "memory");
            const unsigned og = xb_add(&bar[XB_TOP], 1u);
            const unsigned tg = og / nx;
            if (og + 1u == (tg + 1u) * nx) xb_add(&bar[XB_TOPGEN], 1u);
            else XB_SPIN(xb_ld(&bar[XB_TOPGEN]) == tg, bar);
            __builtin_amdgcn_fence(__ATOMIC_ACQUIRE, "agent");
            xb_add(&bar[XB_XGEN(b.x)], 1u);
            asm volatile("s_waitcnt vmcnt(0)" ::: "memory");
        } else {
            XB_SPIN(xb_ld(&bar[XB_XGEN(b.x)]) == gen, bar);
            __builtin_amdgcn_fence(__ATOMIC_ACQUIRE, "agent");
            asm volatile("s_waitcnt vmcnt(0)" ::: "memory");
        }
    }
    __syncthreads();
}

__device__ __forceinline__ void transpose_item(const float* W, int K, int N, bf16_t* WT, int k0, int ns0, int nd0, LAS float* scr, int lane) {
#pragma unroll 8
    for (int i = 0; i < 32; ++i) { const int kk = 2 * i + (lane >> 5); scr[kk * 33 + (lane & 31)] = W[(size_t)(k0 + kk) * N + ns0 + (lane & 31)]; }
    LDS_WAIT(); asm volatile("" ::: "memory");
    const int c = lane & 7;
#pragma unroll
    for (int j = 0; j < 4; ++j) { const int n = (lane >> 3) + 8 * j; const LAS float* s = scr + (8 * c) * 33 + n;
        u32x4 o; o.x = pk2(s[0 * 33], s[1 * 33]); o.y = pk2(s[2 * 33], s[3 * 33]); o.z = pk2(s[4 * 33], s[5 * 33]); o.w = pk2(s[6 * 33], s[7 * 33]);
        *(u32x4*)(WT + (size_t)(nd0 + n) * K + k0 + 8 * c) = o; }
    LDS_WAIT(); asm volatile("" ::: "memory");
}
__device__ __forceinline__ int map_in(int nd) {
    if (nd < 1024) return nd;
    if (nd < 2048) { const int t = (nd - 1024) >> 8, i = (nd - 1024) & 255; return i < 128 ? 1024 + 128 * t + i : 1536 + 128 * t + (i - 128); }
    const int t = (nd - 2048) >> 8, i = (nd - 2048) & 255;
    return i < 128 ? 2048 + 128 * t + i : 3072 + 128 * t + (i - 128);
}

template <int MODE>
__device__ __forceinline__ void mod_item(LAS unsigned char* lds, int cg, const float* c, const float* w_ada, const float* b_ada, float* mod, int ldw, int ldo, int tid, int wave, int lane) {
    asm volatile("" : "+v"(tid), "+v"(lane));
    LAS float* cact = (LAS float*)lds;
    for (int i = tid; i < BATCH * D; i += 512) { float v; if (MODE == 0) { const float t = c[i]; v = t * __builtin_amdgcn_rcpf(1.0f + __expf(-t)); } else v = c[(size_t)(i >> 10) * (NMOD * D) + (i & 1023)];
        cact[(i >> 10) * 1025 + (i & 1023)] = v; }
    __syncthreads();
    const int ct = wave & 1, ks = wave >> 1;
    const float* wp = w_ada + (size_t)(ks * 256 + (lane >> 5)) * ldw + cg * 64 + ct * 32 + (lane & 31);
    const LAS float* ap = cact + (lane & 31) * 1025 + ks * 256 + (lane >> 5);
    f32x16 acc;
#pragma unroll
    for (int i = 0; i < 16; ++i) acc[i] = 0.f;
    float wn[32];
#pragma unroll
    for (int i = 0; i < 32; ++i) wn[i] = wp[(size_t)(2 * i) * ldw];
#pragma unroll 1
    for (int g = 0; g < 4; ++g) {
        float wc[32];
#pragma unroll
        for (int i = 0; i < 32; ++i) wc[i] = wn[i];
        if (g < 3) {
#pragma unroll
            for (int i = 0; i < 32; ++i) wn[i] = wp[(size_t)(64 * (g + 1) + 2 * i) * ldw];
        }
#pragma unroll
        for (int i = 0; i < 32; ++i) acc = __builtin_amdgcn_mfma_f32_32x32x2f32(ap[64 * g + 2 * i], wc[i], acc, 0, 0, 0);
    }
    __syncthreads();
    LAS float* part = (LAS float*)lds;
#pragma unroll
    for (int r = 0; r < 16; ++r) part[(wave * 16 + r) * 64 + lane] = acc[r];
    __syncthreads();
#pragma unroll
    for (int i = 0; i < 4; ++i) { const int o = tid + 512 * i, t = o >> 10, r = (o >> 6) & 15, l = o & 63; float s = 0.f;
#pragma unroll
        for (int k = 0; k < 4; ++k) s += part[((k * 2 + t) * 16 + r) * 64 + l];
        const int b = (r & 3) + 8 * (r >> 2) + 4 * (l >> 5), col = cg * 64 + t * 32 + (l & 31);
        mod[(size_t)b * ldo + col] = s + (MODE == 0 ? b_ada[col] : 0.f); }
    __syncthreads();
}

__device__ __forceinline__ void ssm_mats_item(LAS unsigned char* lds, int g, const float* lam_re, const float* lam_im, const float* log_dt, const float* b_re, const float* b_im,
                                              const float* c_re, const float* c_im, const float* d_skip, bf16_t* Bt1, bf16_t* Bt2, float* lam16, int tid) {
    LAS float* pwr = (LAS float*)lds; LAS float* pwi = pwr + 17 * 64;
    LAS float* bbr = pwi + 17 * 64;   LAS float* bbi = bbr + 1024;
    LAS float* ccr = bbi + 1024;      LAS float* cci = ccr + 1024;
    LAS float* km = cci + 1024;
    LAS float* dsk = km + 4096;
    const float dt = expf(log_dt[g]);
    for (int i = tid; i < 17 * 64; i += 512) { const int tau = i >> 6, p = i & 63; const float lr = lam_re[g * NP + p], li = lam_im[g * NP + p];
        const float e = expf((float)tau * lr * dt), ang = (float)tau * li * dt; pwr[i] = e * cosf(ang); pwi[i] = e * sinf(ang); }
    for (int i = tid; i < 1024; i += 512) { const int p = i >> 4, h = i & 15; const float lr = lam_re[g * NP + p], li = lam_im[g * NP + p];
        const float a = lr * dt, th = li * dt, em1 = expm1f(a), ct = cosf(th), st = sinf(th), sh = sinf(0.5f * th);
        const float nr = em1 * ct - 2.f * sh * sh, ni = (em1 + 1.f) * st;
        const float den = lr * lr + li * li, qr = (nr * lr + ni * li) / den, qi = (ni * lr - nr * li) / den;
        const float br = b_re[(g * NP + p) * NH + h], bi = b_im[(g * NP + p) * NH + h];
        bbr[i] = qr * br - qi * bi; bbi[i] = qr * bi + qi * br; }
    for (int i = tid; i < 1024; i += 512) { ccr[i] = c_re[g * 1024 + i]; cci[i] = c_im[g * 1024 + i]; }
    if (tid < 16) dsk[tid] = d_skip[g * NH + tid];
    __syncthreads();
    for (int i = tid; i < 4096; i += 512) { const int tau = i >> 8, h = (i >> 4) & 15, hp = i & 15; float s = 0.f;
        for (int p = 0; p < 64; ++p) { const float cr = ccr[h * 64 + p], ci = cci[h * 64 + p], pr = pwr[tau * 64 + p], pi = pwi[tau * 64 + p];
            const float xr = cr * pr - ci * pi, xi = cr * pi + ci * pr; s += xr * bbr[p * 16 + hp] - xi * bbi[p * 16 + hp]; }
        km[i] = s; }
    __syncthreads();
    bf16_t* B2g = Bt2 + (size_t)g * 256 * 512; bf16_t* B1g = Bt1 + (size_t)g * 128 * 256;
    for (int i = tid; i < 256 * 32; i += 512) { const int n = i >> 5, k8 = i & 31, j = n >> 4, h = n & 15, jp = k8 >> 1, hp0 = (k8 & 1) * 8; float v[8];
#pragma unroll
        for (int e = 0; e < 8; ++e) { float x = 0.f; if (j >= jp) { x = km[((j - jp) * 16 + h) * 16 + hp0 + e]; if (j == jp && h == hp0 + e) x += dsk[h]; } v[e] = x; }
        u32x4 o; o.x = pk2(v[0], v[1]); o.y = pk2(v[2], v[3]); o.z = pk2(v[4], v[5]); o.w = pk2(v[6], v[7]);
        *(u32x4*)(B2g + (size_t)n * 512 + k8 * 8) = o; }
    for (int i = tid; i < 256 * 64; i += 512) { const int n = i >> 6, p = i & 63, j = n >> 4, h = n & 15;
        const float cr = ccr[h * 64 + p], ci = cci[h * 64 + p], pr = pwr[(j + 1) * 64 + p], pi = pwi[(j + 1) * 64 + p];
        const float xr = cr * pr - ci * pi, xi = cr * pi + ci * pr; const unsigned a = f2bf(xr), b = f2bf(-xi);
        u32x2 o; o.x = a | (a << 16); o.y = b | (b << 16);
        *(u32x2*)(B2g + (size_t)n * 512 + 256 + 4 * p) = o; }
    for (int i = tid; i < 128 * 32; i += 512) { const int n = i >> 5, k8 = i & 31, p = n >> 1, im = n & 1, jp = k8 >> 1, hp0 = (k8 & 1) * 8; float v[8];
        const float pr = pwr[(15 - jp) * 64 + p], pi = pwi[(15 - jp) * 64 + p];
#pragma unroll
        for (int e = 0; e < 8; ++e) { const float br = bbr[p * 16 + hp0 + e], bi = bbi[p * 16 + hp0 + e]; v[e] = im ? (pr * bi + pi * br) : (pr * br - pi * bi); }
        u32x4 o; o.x = pk2(v[0], v[1]); o.y = pk2(v[2], v[3]); o.z = pk2(v[4], v[5]); o.w = pk2(v[6], v[7]);
        *(u32x4*)(B1g + (size_t)n * 256 + k8 * 8) = o; }
    if (tid < 64) { lam16[(g * 64 + tid) * 2] = pwr[16 * 64 + tid]; lam16[(g * 64 + tid) * 2 + 1] = pwi[16 * 64 + tid]; }
    __syncthreads();
}

__device__ __forceinline__ void norm_mod_rows(const float* src, const float* gvec, const float* shift, const float* scale, bf16_t* dst, int wave, int lane) {
    asm volatile("" : "+v"(lane));
    f32x4 gs[4], sh[4];
#pragma unroll
    for (int j = 0; j < 4; ++j) { const int col = 4 * lane + 256 * j; const f32x4 g = *(const f32x4*)(gvec + col), sc = *(const f32x4*)(scale + col); gs[j] = g * (sc + 1.0f); sh[j] = *(const f32x4*)(shift + col); }
    for (int r = wave; r < 256; r += NWAVES) {
        const f32x4* xr = (const f32x4*)(src + (size_t)r * D) + lane; f32x4 v[4]; float s = 0.f;
#pragma unroll
        for (int j = 0; j < 4; ++j) { v[j] = xr[64 * j]; s += (v[j][0] * v[j][0] + v[j][1] * v[j][1]) + (v[j][2] * v[j][2] + v[j][3] * v[j][3]); }
        const float rstd = rsqrtf(wave_sum(s) * (1.f / D) + RMS_EPS);
        unsigned long long* o8 = (unsigned long long*)(dst + (size_t)r * D) + lane;
#pragma unroll
        for (int j = 0; j < 4; ++j) { const f32x4 y = v[j] * rstd * gs[j] + sh[j]; o8[64 * j] = (unsigned long long)cvt_pk_bf16(y[0], y[1]) | ((unsigned long long)cvt_pk_bf16(y[2], y[3]) << 32); }
    }
}
__device__ __forceinline__ void final_norm_rows(float* io, const float* gvec, int wave, int lane) {
    asm volatile("" : "+v"(lane));
    f32x4 g[4];
#pragma unroll
    for (int j = 0; j < 4; ++j) g[j] = *(const f32x4*)(gvec + 4 * lane + 256 * j);
    for (int r = wave; r < 256; r += NWAVES) {
        f32x4* xr = (f32x4*)(io + (size_t)r * D) + lane; f32x4 v[4]; float s = 0.f;
#pragma unroll
        for (int j = 0; j < 4; ++j) { v[j] = xr[64 * j]; s += (v[j][0] * v[j][0] + v[j][1] * v[j][1]) + (v[j][2] * v[j][2] + v[j][3] * v[j][3]); }
        const float rstd = rsqrtf(wave_sum(s) * (1.f / D) + RMS_EPS);
#pragma unroll
        for (int j = 0; j < 4; ++j) xr[64 * j] = v[j] * rstd * g[j];
    }
}
__device__ __forceinline__ void conv_panel(const bf16_t* CB, const bf16_t* V, const float* conv_w, bf16_t* YC, int pm, int tid) {
    asm volatile("" : "+v"(tid));
    const int cp = tid & 63, rg = tid >> 6, c0 = cp * 8, r0 = rg * 32, t0 = (pm & 7) * 256 + r0;
    float w[3][8];
#pragma unroll
    for (int k = 0; k < 3; ++k)
#pragma unroll
        for (int e = 0; e < 8; ++e) w[k][e] = conv_w[k * DC + c0 + e];
    const bf16_t* vp = V + ((size_t)pm * 256 + r0) * DC + c0; const bf16_t* cbp = CB + ((size_t)pm * 256 + r0) * DC + c0;
    u32x4 vm2 = (u32x4){0u, 0u, 0u, 0u}, vm1 = (u32x4){0u, 0u, 0u, 0u};
    if (t0 >= 2) { vm2 = *(const u32x4*)(vp - 2 * DC); vm1 = *(const u32x4*)(vp - DC); }
    for (int r = 0; r < 32; ++r) {
        const u32x4 v0 = *(const u32x4*)(vp + (size_t)r * DC), cb = *(const u32x4*)(cbp + (size_t)r * DC);
        float y[8];
#pragma unroll
        for (int q = 0; q < 4; ++q) {
            y[2 * q]     = bf_lo(cb[q]) * (w[0][2 * q] * bf_lo(vm2[q]) + w[1][2 * q] * bf_lo(vm1[q]) + w[2][2 * q] * bf_lo(v0[q]));
            y[2 * q + 1] = bf_hi(cb[q]) * (w[0][2 * q + 1] * bf_hi(vm2[q]) + w[1][2 * q + 1] * bf_hi(vm1[q]) + w[2][2 * q + 1] * bf_hi(v0[q]));
        }
        u32x4 o; o.x = cvt_pk_bf16(y[0], y[1]); o.y = cvt_pk_bf16(y[2], y[3]); o.z = cvt_pk_bf16(y[4], y[5]); o.w = cvt_pk_bf16(y[6], y[7]);
        *(u32x4*)(YC + (size_t)(r0 + r) * DC + c0) = o;
        vm2 = vm1; vm1 = v0;
    }
}

__device__ __forceinline__ void ssm_phase(LAS unsigned char* lds, const bf16_t* U, const bf16_t* Bt1, const bf16_t* Bt2, const float* lam16, bf16_t* YG, int vcu, int G, int tid, int wave, int lane) {
    asm volatile("" : "+v"(tid), "+v"(lane));
    const int fr = lane & 15, fq = lane >> 4;
    for (int it0 = vcu * 4; it0 < NG * BATCH; it0 += 4 * G) {
        const int g = it0 >> 5;
        bf16x8 b1f[8], b2f[2][16];
        const bf16_t* B1g = Bt1 + (size_t)g * 128 * 256; const bf16_t* B2g = Bt2 + (size_t)g * 256 * 512;
#pragma unroll
        for (int kk = 0; kk < 8; ++kk) b1f[kk] = *(const bf16x8*)(B1g + (size_t)(16 * wave + fr) * 256 + 32 * kk + 8 * fq);
#pragma unroll
        for (int nt = 0; nt < 2; ++nt)
#pragma unroll
            for (int kk = 0; kk < 16; ++kk) b2f[nt][kk] = *(const bf16x8*)(B2g + (size_t)(16 * (2 * wave + nt) + fr) * 512 + 32 * kk + 8 * fq);
        const float l16r = lam16[(g * 64 + lane) * 2], l16i = lam16[(g * 64 + lane) * 2 + 1];
        if (tid < 128) ((LAS unsigned*)(lds + SSM_SOFF))[tid] = 0u;
#pragma unroll 1
        for (int i = 0; i < 4; ++i) {
            const int b = (it0 & 31) + i;
            const bf16_t* Ub = U + ((size_t)g * M + (size_t)b * SEQ) * 16;
#pragma unroll
            for (int q = 0; q < 8; ++q) { const int piece = tid + 512 * q, row = piece >> 5, slot = piece & 31; const u32x4 val = *(const u32x4*)(Ub + (size_t)piece * 8);
                *(LAS u32x4*)(lds + row * 512 + ((slot ^ (row & 15)) << 4)) = val; }
            __syncthreads();
#pragma unroll 1
            for (int r = 0; r < 8; ++r) { f32x4 acc = (f32x4){0.f, 0.f, 0.f, 0.f}; const int row = 16 * r + fr;
#pragma unroll
                for (int kk = 0; kk < 8; ++kk) { const bf16x8 af = *(const LAS bf16x8*)(lds + row * 512 + (((4 * kk + fq) ^ fr) << 4)); acc = __builtin_amdgcn_mfma_f32_16x16x32_bf16(b1f[kk], af, acc, 0, 0, 0); }
                const int rho = row + 1; *(LAS f32x4*)(lds + SSM_SOFF + rho * 512 + (((4 * wave + fq) ^ (rho & 15)) << 4)) = acc; }
            __syncthreads();
            if (wave == 0) { float sr = 0.f, si = 0.f;
#pragma unroll 8
                for (int c = 0; c < NCH; ++c) { const int rho = c + 1; LAS f32x2* ap = (LAS f32x2*)(lds + SSM_SOFF + rho * 512 + (((lane >> 1) ^ (rho & 15)) << 4) + (lane & 1) * 8);
                    const f32x2 v = *ap; const float nr = l16r * sr - l16i * si + v[0], ni = l16r * si + l16i * sr + v[1]; sr = nr; si = ni;
                    const unsigned rh = f2bf(sr), ih = f2bf(si); const unsigned rl = f2bf(sr - __uint_as_float(rh << 16)), il = f2bf(si - __uint_as_float(ih << 16));
                    u32x2 o; o.x = rh | (rl << 16); o.y = ih | (il << 16); *(LAS u32x2*)ap = o; } }
            __syncthreads();
#pragma unroll 1
            for (int r = 0; r < 8; ++r) { f32x4 a0 = (f32x4){0.f, 0.f, 0.f, 0.f}, a1 = a0; const int row = 16 * r + fr;
#pragma unroll
                for (int kk = 0; kk < 8; ++kk) { const bf16x8 af = *(const LAS bf16x8*)(lds + row * 512 + (((4 * kk + fq) ^ fr) << 4));
                    a0 = __builtin_amdgcn_mfma_f32_16x16x32_bf16(b2f[0][kk], af, a0, 0, 0, 0); a1 = __builtin_amdgcn_mfma_f32_16x16x32_bf16(b2f[1][kk], af, a1, 0, 0, 0); }
#pragma unroll
                for (int kk = 0; kk < 8; ++kk) { const bf16x8 af = *(const LAS bf16x8*)(lds + SSM_SOFF + row * 512 + (((4 * kk + fq) ^ (row & 15)) << 4));
                    a0 = __builtin_amdgcn_mfma_f32_16x16x32_bf16(b2f[0][8 + kk], af, a0, 0, 0, 0); a1 = __builtin_amdgcn_mfma_f32_16x16x32_bf16(b2f[1][8 + kk], af, a1, 0, 0, 0); }
                const size_t tok = (size_t)b * SEQ + 16 * row + 2 * wave;
                u32x2 o0, o1; o0.x = cvt_pk_bf16(gelu_tanh(a0[0]), gelu_tanh(a0[1])); o0.y = cvt_pk_bf16(gelu_tanh(a0[2]), gelu_tanh(a0[3]));
                o1.x = cvt_pk_bf16(gelu_tanh(a1[0]), gelu_tanh(a1[1])); o1.y = cvt_pk_bf16(gelu_tanh(a1[2]), gelu_tanh(a1[3]));
                *(u32x2*)(YG + tok * DS + g * 16 + 4 * fq) = o0; *(u32x2*)(YG + (tok + 1) * DS + g * 16 + 4 * fq) = o1; }
            __syncthreads();
        }
    }
}

constexpr int NPHASE = 11;
struct Args { const float* in[24]; float* out; unsigned char* ws; int ph_lo, ph_hi, li, pad; };
__global__ void __launch_bounds__(NWAVES * 64, 2) mega_fwd(Args args) {
    extern __shared__ __attribute__((aligned(16))) unsigned char lds_raw[];
    LAS unsigned char* lds = (LAS unsigned char*)lds_raw;
    volatile LAS unsigned* MISC = (volatile LAS unsigned*)(lds + MISC_OFF);
    const int tid = threadIdx.x, lane = tid & 63, wave = __builtin_amdgcn_readfirstlane(tid >> 6);
    const int G = gridDim.x; const int bx = blockIdx.x; const int vcu = (G % 8 == 0) ? (bx % 8) * (G / 8) + bx / 8 : bx;
    unsigned char* ws = args.ws;
    unsigned* ctl = (unsigned*)(ws + WS_CTL);
    const float* x = args.in[0]; const float* cvec = args.in[1]; const float* norm1_g = args.in[2]; const float* norm2_g = args.in[3];
    const float* w_ada = args.in[4]; const float* b_ada = args.in[5]; const float* w_in = args.in[6];
    const float* lam_re = args.in[7]; const float* lam_im = args.in[8]; const float* log_dt = args.in[9];
    const float* b_re = args.in[10]; const float* b_im = args.in[11]; const float* c_re = args.in[12]; const float* c_im = args.in[13];
    const float* d_skip = args.in[14]; const float* w_glu = args.in[15]; const float* b_glu = args.in[16]; const float* conv_w = args.in[17];
    const float* w_proj_ssm = args.in[18]; const float* w_proj_conv = args.in[19]; const float* w_out = args.in[20];
    const float* w_ff1 = args.in[21]; const float* w_ff2 = args.in[22]; const float* final_g = args.in[23];
    float* out = args.out;
    float* mod = (float*)(ws + WS_MOD);
    bf16_t* WinT = (bf16_t*)(ws + WS_WIN); bf16_t* WgluT = (bf16_t*)(ws + WS_WGLU); bf16_t* PssmT = (bf16_t*)(ws + WS_PSSM); bf16_t* PconvT = (bf16_t*)(ws + WS_PCONV);
    bf16_t* WoutT = (bf16_t*)(ws + WS_WOUT); bf16_t* W1T = (bf16_t*)(ws + WS_W1); bf16_t* W2T = (bf16_t*)(ws + WS_W2);
    bf16_t* Bt1 = (bf16_t*)(ws + WS_BT1); bf16_t* Bt2 = (bf16_t*)(ws + WS_BT2); float* lam16 = (float*)(ws + WS_L16);
    bf16_t* HN = (bf16_t*)(ws + WS_HN); bf16_t* Ub = (bf16_t*)(ws + WS_U); bf16_t* CBb = (bf16_t*)(ws + WS_CB); bf16_t* Vb = (bf16_t*)(ws + WS_V); bf16_t* YGb = (bf16_t*)(ws + WS_YG);
    unsigned char* panels = ws + WS_PANEL; float* C2 = (float*)(ws + WS_C2); float* ROWP = (float*)(ws + WS_ROWP); float* GS2 = (float*)(ws + WS_GS2);

    if (tid < 32) MISC[tid] = 0u;
    __syncthreads();
    XcdBarrier bar; bar.bar = ctl + CW_BAR; bar.x = 0; bar.st = nullptr;
    if (MK_N_LAUNCHES == 1) bar = xcd_barrier_post(ctl + CW_BAR, MISC + 8);
    const int lo = args.ph_lo, hi = args.ph_hi;
#define IN(k) (lo <= (k) && (k) < hi)
#define BOTH(k) (IN(k) && IN((k) + 1))
#define NREP(k) (((REP_MASK >> (k)) & 1) ? 2 : 1)
#define SEAM(k) do { if (BOTH(k)) xcd_barrier(bar); } while (0)

    if (IN(0)) {
#pragma unroll 1
      for (int rep = 0; rep < NREP(0); ++rep) {
        for (int it = vcu; it < 128; it += G) {
            if (it < 96) mod_item<0>(lds, it, cvec, w_ada, b_ada, mod, NMOD * D, NMOD * D, tid, wave, lane);
            else ssm_mats_item(lds, it - 96, lam_re, lam_im, log_dt, b_re, b_im, c_re, c_im, d_skip, Bt1, Bt2, lam16, tid);
        }
        {
            LAS float* scr = (LAS float*)(lds + wave * 16384);
            int gw, NGW; if (G > 128) { gw = (vcu - 128) * NWAVES + wave; NGW = (G - 128) * NWAVES; } else { gw = vcu * NWAVES + wave; NGW = G * NWAVES; }
            constexpr int I_IN = (D / 64) * (INC / 32), I_GLU = (DS / 64) * (DS / 32), I_PS = (DS / 64) * (D / 32), I_PC = I_PS, I_OUT = (D / 64) * (D / 32), I_1 = (D / 64) * (DFF / 32), I_2 = (DFF / 64) * (D / 32);
            constexpr int NITEMS = I_IN + I_GLU + I_PS + I_PC + I_OUT + I_1 + I_2;
            if (gw >= 0) for (int it = gw; it < NITEMS; it += NGW) {
                int r = it;
                if (r < I_IN) { const int nb = r % (INC / 32), kb = r / (INC / 32); transpose_item(w_in, D, INC, WinT, 64 * kb, map_in(32 * nb), 32 * nb, scr, lane); continue; } r -= I_IN;
                if (r < I_GLU) { const int nb = r % (DS / 32), kb = r / (DS / 32); transpose_item(w_glu, DS, DS, WgluT, 64 * kb, 32 * nb, 32 * nb, scr, lane); continue; } r -= I_GLU;
                if (r < I_PS) { const int nb = r % (D / 32), kb = r / (D / 32); transpose_item(w_proj_ssm, DS, D, PssmT, 64 * kb, 32 * nb, 32 * nb, scr, lane); continue; } r -= I_PS;
                if (r < I_PC) { const int nb = r % (D / 32), kb = r / (D / 32); transpose_item(w_proj_conv, DC, D, PconvT, 64 * kb, 32 * nb, 32 * nb, scr, lane); continue; } r -= I_PC;
                if (r < I_OUT) { const int nb = r % (D / 32), kb = r / (D / 32); transpose_item(w_out, D, D, WoutT, 64 * kb, 32 * nb, 32 * nb, scr, lane); continue; } r -= I_OUT;
                if (r < I_1) { const int nb = r % (DFF / 32), kb = r / (DFF / 32); transpose_item(w_ff1, D, DFF, W1T, 64 * kb, 32 * nb, 32 * nb, scr, lane); continue; } r -= I_1;
                { const int nb = r % (D / 32), kb = r / (D / 32); transpose_item(w_ff2, DFF, D, W2T, 64 * kb, 32 * nb, 32 * nb, scr, lane); }
            }
        }
        __syncthreads();
      }
      SEAM(0);
    }
    if (IN(1)) {
#pragma unroll 1
      for (int rep = 0; rep < NREP(1); ++rep) {
        for (int pm = vcu; pm < NPANEL; pm += G) { const float* modb = mod + (size_t)(pm >> 3) * (NMOD * D);
            norm_mod_rows(x + (size_t)pm * 256 * D, norm1_g, modb + 0 * D, modb + 1 * D, HN + (size_t)pm * 256 * D, wave, lane); }
        __syncthreads();
        for (int i = vcu * 512 + tid; i < BATCH * D; i += G * 512) GS2[i] = norm2_g[i & (D - 1)] * (1.0f + mod[(size_t)(i >> 10) * (NMOD * D) + 4 * D + (i & (D - 1))]);
        for (int it = vcu; it < DFF / 64; it += G) mod_item<1>(lds, it, mod + 3 * D, w_ff1, nullptr, C2, DFF, DFF, tid, wave, lane);
      }
      SEAM(1);
    }
    if (IN(2)) {
#pragma unroll 1
      for (int rep = 0; rep < NREP(2); ++rep) {
        SchedGrp S{(const char*)HN, (const char*)HN, (const char*)WinT, (const char*)WinT, (size_t)256 * D * 2, (size_t)256 * D * 2, INC / 256, 1, vcu, G, GP16, KROT(vcu), 0};
        EpiIn E{Ub, CBb, Vb, panels};
        pg8::gemm_phase<EpiIn, SchedGrp, PG_ALIGN, PG_SP2>(lds, D, S, E);
      }
      SEAM(2);
    }
    if (IN(3)) {
#pragma unroll 1
      for (int rep = 0; rep < NREP(3); ++rep) {
        for (int pm = vcu; pm < NPANEL; pm += G) conv_panel(CBb, Vb, conv_w, PANEL_PTR(pm, PL_YC), pm, tid);
        ssm_phase(lds, Ub, Bt1, Bt2, lam16, YGb, vcu, G, tid, wave, lane);
      }
      SEAM(3);
    }
    if (IN(4)) {
#pragma unroll 1
      for (int rep = 0; rep < NREP(4); ++rep) {
        SchedGrp S{(const char*)YGb, (const char*)YGb, (const char*)WgluT, (const char*)WgluT, (size_t)256 * DS * 2, (size_t)256 * DS * 2, DS / 256, 1, vcu, G, 16, KROT(vcu), 0};
        EpiGlu E{YGb, b_glu, panels};
        pg8::gemm_phase<EpiGlu, SchedGrp, PG_ALIGN, PG_SP2>(lds, DS, S, E);
      }
      SEAM(4);
    }
    if (IN(5)) {
#pragma unroll 1
      for (int rep = 0; rep < NREP(5); ++rep) {
        SchedGrp S{(const char*)(panels + PL_YS), (const char*)(panels + PL_YC), (const char*)PssmT, (const char*)PconvT, PANEL_BYTES, (size_t)256 * DS * 2, D / 256, 2, vcu, G, 8, KROT(vcu), 0};
        EpiMerge E{panels};
        pg8::gemm_phase<EpiMerge, SchedGrp, PG_ALIGN, PG_SP2>(lds, DS, S, E);
      }
      SEAM(5);
    }
    if (IN(6)) {
#pragma unroll 1
      for (int rep = 0; rep < NREP(6); ++rep) {
        SchedGrp S{(const char*)(panels + PL_MG), (const char*)(panels + PL_MG), (const char*)WoutT, (const char*)WoutT, PANEL_BYTES, (size_t)256 * D * 2, D / 256, 1, vcu, G, 8, KROT(vcu), 0};
        EpiOut E{x, mod, GS2, out, HN, ROWP, (LAS float*)(lds + ROWSQ_OFF)};
        pg8::gemm_phase<EpiOut, SchedGrp, true, PG_SP2>(lds, D, S, E);
      }
      SEAM(6);
    }
    if (IN(8)) {
#pragma unroll 1
      for (int rep = 0; rep < NREP(8); ++rep) {
        SchedGrp S{(const char*)HN, (const char*)HN, (const char*)W1T, (const char*)W1T, (size_t)256 * D * 2, (size_t)256 * D * 2, DFF / 256, 1, vcu, G, GP16, (NREP(8) == 2 && rep == 0) ? XP_KROT(vcu) : KROT(vcu), (NREP(8) == 2 && rep == 0) ? XP_A : 0};
        EpiRelu2 E{panels, ws + WS_U, C2, ROWP, 0};
        pg8::gemm_phase<EpiRelu2, SchedGrp, PG_ALIGN, PG_SP2>(lds, D, S, E);
      }
      SEAM(8);
    }
    if (IN(9)) {
#pragma unroll 1
      for (int rep = 0; rep < NREP(9); ++rep) {
        SchedGrp S{(const char*)panels, (const char*)panels, (const char*)W2T, (const char*)W2T, PANEL_BYTES, (size_t)256 * DFF * 2, D / 256, 1, vcu, G, 8, KROT(vcu), 0};
        EpiRes E{out, mod, out, 5 * D, (NREP(9) == 2 && rep == 0) ? 1 : 0};
        pg8::gemm_phase<EpiRes, SchedGrp, PG_ALIGN, PG_SP2>(lds, DFF, S, E);
      }
      SEAM(9);
    }
    if (IN(10)) {
        for (int pm = vcu; pm < NPANEL; pm += G) final_norm_rows(out + (size_t)pm * 256 * D, final_g, wave, lane);
    }
#undef IN
#undef BOTH
#undef NREP
#undef SEAM
}

extern "C" void kernel_launch(void* const* d_in, const int* in_sizes, int n_in, void* d_out, int out_size, void* d_ws, size_t ws_size, hipStream_t stream) {
    static int grid = 0;
    if (grid == 0) {
        if (n_in != 24 || in_sizes[0] != M * D || out_size != M * D || ws_size < WS_END) { fprintf(stderr, "kernel_launch: unexpected shapes (n_in %d, in0 %d, out %d, ws %zu); nothing launched\n", n_in, n_in > 0 ? in_sizes[0] : -1, out_size, ws_size); grid = -1; return; }
        int dev = 0, cus = 0, per_cu = 0;
        if (hipGetDevice(&dev) != hipSuccess || hipDeviceGetAttribute(&cus, hipDeviceAttributeMultiprocessorCount, dev) != hipSuccess) { fprintf(stderr, "kernel_launch: device query failed\n"); grid = -1; return; }
        if (hipFuncSetAttribute((const void*)mega_fwd, hipFuncAttributeMaxDynamicSharedMemorySize, LDS_BYTES) != hipSuccess) { fprintf(stderr, "kernel_launch: hipFuncSetAttribute failed\n"); grid = -1; return; }
        if (hipOccupancyMaxActiveBlocksPerMultiprocessor(&per_cu, (const void*)mega_fwd, NWAVES * 64, LDS_BYTES) != hipSuccess || per_cu < 1) { fprintf(stderr, "kernel_launch: occupancy query reports %d workgroups per CU\n", per_cu); (void)hipGetLastError(); grid = -1; return; }
        grid = cus;
        if (grid > NPANEL) grid = NPANEL;
    }
    if (grid < 0) return;
    if (hipMemsetAsync((char*)d_ws + WS_CTL, 0, CTL_ZERO_BYTES, stream) != hipSuccess) { fprintf(stderr, "kernel_launch: memset failed\n"); return; }
    Args a{};
    for (int i = 0; i < 24; ++i) a.in[i] = (const float*)d_in[i];
    a.out = (float*)d_out; a.ws = (unsigned char*)d_ws;
    for (int li = 0; li < MK_N_LAUNCHES; ++li) {
        if (MK_N_LAUNCHES == 1) { a.ph_lo = 0; a.ph_hi = NPHASE; } else { a.ph_lo = li; a.ph_hi = li + 1; }
        a.li = li;
        hipLaunchKernelGGL(mega_fwd, dim3(grid), dim3(NWAVES * 64), LDS_BYTES, stream, a);
        const hipError_t le = hipPeekAtLastError();
        if (le != hipSuccess) { fprintf(stderr, "kernel_launch: launch %d failed: %s\n", li, hipGetErrorName(le)); break; }
    }
}
```
